# Optimizing an MI355X kernel written in HIP

```python
import math
import jax, jax.numpy as jnp
from jax import lax
import numpy as np

D_MODEL = 1024
BATCH = 8
SEQ = 4096
DEPTH = 1

DIFF_HEADS = 8
DIFF_HD = 64
NSA_HEADS = 16
NSA_KV = 4
NSA_HD = 64
CMP_LEN = 32
CMP_STRIDE = 16
SLC_LEN = 64
SLC_TOPN = 16
WIN = 512
PHI_HID = 256
Q_BLOCK = 128
NSA_Q_BLOCK = 64
N_EXPERTS = 32
TOP_K = 4
D_FF = 1024
SWIGLU_LIMIT = 7.0
SWIGLU_ALPHA = 1.702
MOE_BLOCK = 512
PLE_DIM = 256
LN_EPS = 1e-5
NEG = -1e30
BIG = 1e30
DEEPNORM_ALPHA = (2.0 * DEPTH) ** 0.25
DEEPNORM_BETA = (8.0 * DEPTH) ** -0.25
DIFF_QK = DIFF_HEADS * 2 * DIFF_HD
DIFF_V = DIFF_HEADS * 2 * DIFF_HD
NSA_Q = NSA_HEADS * NSA_HD
NSA_KVW = NSA_KV * NSA_HD
NSA_GATES = NSA_HEADS * 3
IN_SIZES = (DIFF_QK, DIFF_QK, DIFF_V, NSA_Q) + (NSA_KVW,) * 6 + (NSA_GATES,)
C_IN = sum(IN_SIZES)

kernel_name = 'hybrid_diffattn_nsa_moe_deepnorm'


def _alibi_slopes(n):
    return jnp.asarray(2.0 ** (-8.0 * np.arange(1, n + 1) / n), jnp.float32)


def _layer_norm(x, g, b):
    xf = x.astype(jnp.float32)
    mu = jnp.mean(xf, -1, keepdims=True)
    var = jnp.mean(jnp.square(xf - mu), -1, keepdims=True)
    return ((xf - mu) * lax.rsqrt(var + LN_EPS) * g + b).astype(x.dtype)


def _rms_norm(x, g):
    xf = x.astype(jnp.float32)
    return (xf * lax.rsqrt(jnp.mean(xf * xf, -1, keepdims=True) + LN_EPS) * g).astype(x.dtype)


def _masked_softmax(s, mask):
    pr = jax.nn.softmax(jnp.where(mask, s, NEG), axis=-1)
    return jnp.where(mask, pr, 0.0)


def _diff_attention(q, k, v, lq1, lk1, lq2, lk2, subln_g, lambda_init):
    B, S = q.shape[:2]
    lam = (jnp.exp(jnp.sum(lq1.astype(jnp.float32) * lk1))
           - jnp.exp(jnp.sum(lq2.astype(jnp.float32) * lk2)) + lambda_init)
    slopes = _alibi_slopes(DIFF_HEADS)[None, :, None, None, None]
    scale = DIFF_HD ** -0.5
    outs = []
    for qs in range(0, S, Q_BLOCK):
        qe = qs + Q_BLOCK
        s = jnp.einsum('bqhcd,bkhcd->bhcqk', q[:, qs:qe], k[:, :qe]).astype(jnp.float32) * scale
        dist = jnp.arange(qs, qe)[:, None] - jnp.arange(qe)[None, :]
        s = s - slopes * dist.astype(jnp.float32)
        pr = _masked_softmax(s, dist >= 0)
        a = pr[:, :, 0] - lam * pr[:, :, 1]
        outs.append(jnp.einsum('bhqk,bkhe->bqhe', a.astype(v.dtype), v[:, :qe]))
    o = _rms_norm(jnp.concatenate(outs, axis=1), subln_g) * (1.0 - lambda_init)
    return o.reshape(B, S, DIFF_V).astype(q.dtype)


def _nsa_attention(q, kc, vc, ks, vs, kw, vw, gates, pos_k, pos_v, phi_k1, phi_k2, phi_v1, phi_v2):
    B, S = q.shape[:2]
    G, HPG, QB = NSA_KV, NSA_HEADS // NSA_KV, NSA_Q_BLOCK
    scale = NSA_HD ** -0.5
    slopes = _alibi_slopes(NSA_HEADS).reshape(G, HPG)
    n_cmp = (S - CMP_LEN) // CMP_STRIDE + 1
    cmp_idx = np.arange(n_cmp)[:, None] * CMP_STRIDE + np.arange(CMP_LEN)[None, :]
    cmp_pos = jnp.asarray(cmp_idx[:, -1], jnp.int32)

    def compress(t, pos, w1, w2):
        blk = t[:, cmp_idx] + pos[:, None, :]
        blk = blk.transpose(0, 1, 3, 2, 4).reshape(B, n_cmp, G, CMP_LEN * NSA_HD)
        return jax.nn.silu(blk @ w1) @ w2

    k_cmp = compress(kc, pos_k, phi_k1, phi_k2)
    v_cmp = compress(vc, pos_v, phi_v1, phi_v2)
    n_slc = S // SLC_LEN
    n_top = min(SLC_TOPN, n_slc)
    c_lo = np.arange(n_cmp) * CMP_STRIDE
    s_lo = np.arange(n_slc) * SLC_LEN
    ov = (np.minimum(c_lo[:, None] + CMP_LEN, s_lo[None, :] + SLC_LEN)
          - np.maximum(c_lo[:, None], s_lo[None, :]))
    cmp_to_slc = jnp.asarray(np.clip(ov, 0, None) / CMP_LEN, jnp.float32)
    ks_blk = ks.reshape(B, n_slc, SLC_LEN, G, NSA_HD).transpose(0, 3, 1, 2, 4)
    vs_blk = vs.reshape(B, n_slc, SLC_LEN, G, NSA_HD).transpose(0, 3, 1, 2, 4)
    kw_pad = jnp.pad(kw, ((0, 0), (WIN, 0), (0, 0), (0, 0)))
    vw_pad = jnp.pad(vw, ((0, 0), (WIN, 0), (0, 0), (0, 0)))
    b_ix = jnp.arange(B)[:, None, None, None]
    g_ix = jnp.arange(G)[None, :, None, None]
    blk_ids = jnp.arange(n_slc, dtype=jnp.int32)
    nb = S // QB
    q_b = q.reshape(B, nb, QB, G, HPG, NSA_HD).transpose(1, 0, 2, 3, 4, 5)
    g_b = gates.reshape(B, nb, QB, G, HPG, 3).transpose(1, 0, 2, 3, 4, 5)
    starts = jnp.arange(nb, dtype=jnp.int32) * QB

    def block(args):
        qb, gb, qs = args
        t = qs + jnp.arange(QB, dtype=jnp.int32)
        d_c = t[:, None] - cmp_pos[None, :]
        sc = jnp.einsum('bqghd,bngd->bghqn', qb, k_cmp).astype(jnp.float32) * scale
        sc = sc - slopes[None, :, :, None, None] * d_c.astype(jnp.float32)
        pc = _masked_softmax(sc, d_c >= 0)
        o_cmp = jnp.einsum('bghqn,bngd->bqghd', pc.astype(v_cmp.dtype), v_cmp)
        imp = jnp.einsum('bghqn,nj->bgqj', pc, cmp_to_slc)
        cur = (t // SLC_LEN)[:, None]
        forced = (blk_ids[None] == 0) | (blk_ids[None] == cur) | (blk_ids[None] == cur - 1)
        imp = jnp.where(forced, BIG, jnp.where(blk_ids[None] <= cur, imp, NEG))
        _, sel = lax.top_k(imp, n_top)
        k_sel = ks_blk[b_ix, g_ix, sel]
        v_sel = vs_blk[b_ix, g_ix, sel]
        d_s = t[None, None, :, None, None] - (sel[..., None] * SLC_LEN
                                              + jnp.arange(SLC_LEN, dtype=jnp.int32))
        ss = jnp.einsum('bqghd,bgqnld->bghqnl', qb, k_sel).astype(jnp.float32) * scale
        ss = ss - slopes[None, :, :, None, None, None] * d_s[:, :, None].astype(jnp.float32)
        ps = _masked_softmax(ss.reshape(B, G, HPG, QB, n_top * SLC_LEN),
                             (d_s >= 0).reshape(B, G, 1, QB, n_top * SLC_LEN))
        o_slc = jnp.einsum('bghqnl,bgqnld->bqghd',
                           ps.reshape(B, G, HPG, QB, n_top, SLC_LEN).astype(v_sel.dtype), v_sel)
        k_win = lax.dynamic_slice_in_dim(kw_pad, qs, WIN + QB, axis=1)
        v_win = lax.dynamic_slice_in_dim(vw_pad, qs, WIN + QB, axis=1)
        d_w = t[:, None] - (qs - WIN + jnp.arange(WIN + QB, dtype=jnp.int32))[None, :]
        sw = jnp.einsum('bqghd,bkgd->bghqk', qb, k_win).astype(jnp.float32) * scale
        sw = sw - slopes[None, :, :, None, None] * d_w.astype(jnp.float32)
        pw = _masked_softmax(sw, (d_w >= 0) & (d_w < WIN) & (d_w <= t[:, None]))
        o_win = jnp.einsum('bghqk,bkgd->bqghd', pw.astype(v_win.dtype), v_win)
        out = gb[..., 0:1] * o_cmp + gb[..., 1:2] * o_slc + gb[..., 2:3] * o_win
        return out.astype(qb.dtype)

    o = lax.map(block, (q_b, g_b, starts))
    return o.transpose(1, 0, 2, 3, 4, 5).reshape(B, S, NSA_Q)


def _moe(h, w_router, b_router, w1, b1, w2, b2):
    B, S, D = h.shape
    xt = h.reshape(-1, D)
    T = xt.shape[0]
    logits = (xt @ w_router + b_router).astype(jnp.float32)
    top_v, top_e = lax.top_k(logits, TOP_K)
    gate = jax.nn.softmax(top_v, axis=-1)
    flat_e = top_e.reshape(-1).astype(jnp.int32)
    flat_g = gate.reshape(-1)
    flat_t = jnp.arange(T * TOP_K, dtype=jnp.int32) // TOP_K
    order = jnp.argsort(flat_e)
    se = flat_e[order]
    counts = jnp.zeros(N_EXPERTS, jnp.int32).at[flat_e].add(1)
    starts = jnp.cumsum(counts) - counts
    pcounts = (counts + MOE_BLOCK - 1) // MOE_BLOCK * MOE_BLOCK
    pend = jnp.cumsum(pcounts)
    pstart = pend - pcounts
    dest = pstart[se] + (jnp.arange(T * TOP_K, dtype=jnp.int32) - starts[se])
    n_blocks = (T * TOP_K + MOE_BLOCK - 1) // MOE_BLOCK + N_EXPERTS
    n_pad = n_blocks * MOE_BLOCK
    slot_tok = jnp.zeros(n_pad, jnp.int32).at[dest].set(flat_t[order])
    slot_gate = jnp.zeros(n_pad, jnp.float32).at[dest].set(flat_g[order])
    blk_expert = jnp.minimum(
        jnp.searchsorted(pend, jnp.arange(n_blocks, dtype=jnp.int32) * MOE_BLOCK, side='right'),
        N_EXPERTS - 1).astype(jnp.int32)

    def expert_block(args):
        e, tok = args
        hb = xt[tok] @ w1[e] + b1[e]
        x_glu, x_lin = jnp.split(hb, 2, axis=-1)
        x_glu = jnp.minimum(x_glu, SWIGLU_LIMIT)
        x_lin = jnp.clip(x_lin, -SWIGLU_LIMIT, SWIGLU_LIMIT)
        act = x_glu * jax.nn.sigmoid(SWIGLU_ALPHA * x_glu) * (x_lin + 1.0)
        return act @ w2[e] + b2[e]

    y = lax.map(expert_block, (blk_expert, slot_tok.reshape(n_blocks, MOE_BLOCK)))
    y = y.reshape(n_pad, D) * slot_gate[:, None].astype(y.dtype)
    out = jnp.zeros((T, D), y.dtype).at[slot_tok].add(y)
    return out.reshape(B, S, D).astype(h.dtype)


def setup_inputs(seed: int = 0) -> dict:
    key = jax.random.key(seed)
    keys = iter(jax.random.split(key, 40))

    def nrm(shape, scale):
        return jax.random.normal(next(keys), shape, jnp.float32) * scale

    L, D = DEPTH, D_MODEL
    return {
        'x': nrm((BATCH, SEQ, D), 1.0),
        'p': nrm((L, BATCH, SEQ, PLE_DIM), 1.0),
        'w_in': nrm((L, D, C_IN), D ** -0.5),
        'diff_lq1': nrm((L, DIFF_HD), 0.1),
        'diff_lk1': nrm((L, DIFF_HD), 0.1),
        'diff_lq2': nrm((L, DIFF_HD), 0.1),
        'diff_lk2': nrm((L, DIFF_HD), 0.1),
        'diff_subln_g': 1.0 + nrm((L, 2 * DIFF_HD), 0.02),
        'nsa_pos_k': nrm((L, CMP_LEN, NSA_HD), 0.1),
        'nsa_pos_v': nrm((L, CMP_LEN, NSA_HD), 0.1),
        'nsa_phi_k1': nrm((L, CMP_LEN * NSA_HD, PHI_HID), (CMP_LEN * NSA_HD) ** -0.5),
        'nsa_phi_k2': nrm((L, PHI_HID, NSA_HD), PHI_HID ** -0.5),
        'nsa_phi_v1': nrm((L, CMP_LEN * NSA_HD, PHI_HID), (CMP_LEN * NSA_HD) ** -0.5),
        'nsa_phi_v2': nrm((L, PHI_HID, NSA_HD), PHI_HID ** -0.5),
        'w_br_diff': nrm((L, DIFF_V, D), DIFF_V ** -0.5),
        'w_br_nsa': nrm((L, NSA_Q, D), NSA_Q ** -0.5),
        'w_mgate': nrm((L, D, 2 * D), D ** -0.5),
        'b_mgate': nrm((L, 2 * D), 0.01),
        'w_o': nrm((L, D, D), D ** -0.5 * DEEPNORM_BETA),
        'ln1_g': 1.0 + nrm((L, D), 0.02),
        'ln1_b': nrm((L, D), 0.01),
        'w_router': nrm((L, D, N_EXPERTS), D ** -0.5),
        'b_router': nrm((L, N_EXPERTS), 0.01),
        'w_e1': nrm((L, N_EXPERTS, D, 2 * D_FF), D ** -0.5),
        'b_e1': nrm((L, N_EXPERTS, 2 * D_FF), 0.01),
        'w_e2': nrm((L, N_EXPERTS, D_FF, D), D_FF ** -0.5 * DEEPNORM_BETA),
        'b_e2': nrm((L, N_EXPERTS, D), 0.01),
        'w_ple_gate': nrm((L, D, D), D ** -0.5),
        'b_ple_gate': nrm((L, D), 0.01),
        'w_ple_proj': nrm((L, PLE_DIM, D), PLE_DIM ** -0.5 * DEEPNORM_BETA),
        'ln2_g': 1.0 + nrm((L, D), 0.02),
        'ln2_b': nrm((L, D), 0.01),
    }


def reference(x, p, w_in, diff_lq1, diff_lk1, diff_lq2, diff_lk2, diff_subln_g,
              nsa_pos_k, nsa_pos_v, nsa_phi_k1, nsa_phi_k2, nsa_phi_v1, nsa_phi_v2,
              w_br_diff, w_br_nsa, w_mgate, b_mgate, w_o, ln1_g, ln1_b,
              w_router, b_router, w_e1, b_e1, w_e2, b_e2,
              w_ple_gate, b_ple_gate, w_ple_proj, ln2_g, ln2_b):
    B, S, D = x.shape
    splits = np.cumsum(IN_SIZES)[:-1].tolist()
    for i in range(DEPTH):
        lambda_init = 0.8 - 0.6 * math.exp(-0.3 * i)
        proj = x @ w_in[i]
        dq, dk, dv, nq, kc, vc, ks, vs, kw, vw, ng = jnp.split(proj, splits, axis=-1)
        o_diff = _diff_attention(
            dq.reshape(B, S, DIFF_HEADS, 2, DIFF_HD), dk.reshape(B, S, DIFF_HEADS, 2, DIFF_HD),
            dv.reshape(B, S, DIFF_HEADS, 2 * DIFF_HD),
            diff_lq1[i], diff_lk1[i], diff_lq2[i], diff_lk2[i], diff_subln_g[i], lambda_init)
        kvr = lambda t: t.reshape(B, S, NSA_KV, NSA_HD)
        o_nsa = _nsa_attention(
            nq.reshape(B, S, NSA_HEADS, NSA_HD), kvr(kc), kvr(vc), kvr(ks), kvr(vs), kvr(kw), kvr(vw),
            jax.nn.sigmoid(ng).reshape(B, S, NSA_HEADS, 3),
            nsa_pos_k[i], nsa_pos_v[i], nsa_phi_k1[i], nsa_phi_k2[i], nsa_phi_v1[i], nsa_phi_v2[i])
        mg = jax.nn.sigmoid(x @ w_mgate[i] + b_mgate[i])
        mixed = mg[..., :D] * (o_diff @ w_br_diff[i]) + mg[..., D:] * (o_nsa @ w_br_nsa[i])
        h = _layer_norm(DEEPNORM_ALPHA * x + mixed @ w_o[i], ln1_g[i], ln1_b[i])
        ple = jax.nn.sigmoid(h @ w_ple_gate[i] + b_ple_gate[i]) * (p[i] @ w_ple_proj[i])
        ffn = _moe(h, w_router[i], b_router[i], w_e1[i], b_e1[i], w_e2[i], b_e2[i])
        x = _layer_norm(DEEPNORM_ALPHA * h + ffn + ple, ln2_g[i], ln2_b[i])
    return x
```

```cpp
#include <hip/hip_runtime.h>
#include <hip/hip_cooperative_groups.h>
#include <cstdio>
#include <cstdint>
#include <type_traits>
namespace cg = cooperative_groups;

namespace pg8 {
#define PG8_LAS __attribute__((address_space(3)))
typedef unsigned short bf16_t;
typedef short bf16x8 __attribute__((ext_vector_type(8)));
typedef float f32x4 __attribute__((ext_vector_type(4)));
typedef unsigned u32x4 __attribute__((ext_vector_type(4)));
typedef int i32x4 __attribute__((ext_vector_type(4)));
typedef int i32x8 __attribute__((ext_vector_type(8)));
constexpr int BM = 256, BK = 64, HALF = 128, HTB = HALF * BK * 2  , STAGE_BYTES = 8 * HTB, NXCD = 8, WGM = 8;

__host__ __device__ __forceinline__ int lds_byte(int r, int c) { const int st = (r >> 4) * 2 + (c >> 5), rr = r & 15, cc = c & 31, ob = rr * 64 + cc * 2; return st * 1024 + (ob ^ (((ob >> 9) & 1) << 5)); }
__host__ __device__ __forceinline__ void stage_rc(int b, int& R, int& C) { const int st = b / 1024, sb = b % 1024, swz = sb ^ (((sb >> 9) & 1) << 5); R = (st >> 1) * 16 + swz / 64; C = (st & 1) * 32 + (swz % 64) / 2; }
__host__ __device__ __forceinline__ int perm32(int rho) { const int n = rho >> 4, i = rho & 15; return 8 * (i >> 2) + 4 * n + (i & 3); }

template <class E, class = void> struct HasBias : std::false_type {};
template <class E> struct HasBias<E, std::void_t<decltype(E::BIASINIT)>> : std::true_type {};
struct NoBiasRaw {}; template <class E, class = void> struct BiasRawOf { typedef NoBiasRaw type; };
template <class E> struct BiasRawOf<E, std::void_t<typename E::BiasRaw>> { typedef typename E::BiasRaw type; };
template <class E, class = void> struct HasMid : std::false_type {};
template <class E> struct HasMid<E, std::void_t<decltype(E::MIDK)>> : std::true_type {};
struct Unit { int pm, pn; };
struct Gemm { const bf16_t* A; const bf16_t* Bt; int M, N, K; };

struct StaticOrder {
    int nM, nN, nwg, G, c;
    __host__ __device__ void init(int M, int N, int G_, int c_) { nM = M / BM; nN = N / BM; nwg = nM * nN; G = G_; c = c_; }
    __host__ __device__ bool next(int i, Unit& u) const {
        const long L = (long)i * G + c; if (L >= nwg) return false;
        int wgid = (int)L; { const int q = nwg / NXCD, r = nwg % NXCD, xcd = wgid % NXCD, off = wgid / NXCD; wgid = (xcd < r ? xcd * (q + 1) : r * (q + 1) + (xcd - r) * q) + off; }
        const int nig = WGM * nN, gid = wgid / nig, fm = gid * WGM, gsz = (nM - fm) < WGM ? (nM - fm) : WGM;
        u.pm = fm + ((wgid % nig) % gsz); u.pn = (wgid % nig) / gsz; return true;
    }
};
typedef double f64x2 __attribute__((ext_vector_type(2)));
__device__ __forceinline__ f32x4 zero4() { double a, b; asm volatile("v_mov_b64 %0, 0" : "=v"(a)); asm volatile("v_mov_b64 %0, 0" : "=v"(b)); f64x2 v; v.x = a; v.y = b; return __builtin_bit_cast(f32x4, v); }
__device__ __forceinline__ f32x4 copy4(const f32x4& v) { const f64x2 d = __builtin_bit_cast(f64x2, v); double a, b; asm volatile("v_mov_b64 %0, %1" : "=v"(a) : "v"(d.x)); asm volatile("v_mov_b64 %0, %1" : "=v"(b) : "v"(d.y)); f64x2 r; r.x = a; r.y = b; return __builtin_bit_cast(f32x4, r); }
__device__ __forceinline__ unsigned cvt_pk_bf16(float lo, float hi) { unsigned r; asm volatile("v_cvt_pk_bf16_f32 %0, %1, %2" : "=v"(r) : "v"(lo), "v"(hi)); return r; }

template <class Epi, class Sched, bool ALIGN_EPI = false, bool SP2 = false, bool GATHER = false, bool F8 = false>
__device__ __forceinline__ void gemm_phase(PG8_LAS unsigned char* lds, const Gemm g, const Sched& S, const Epi& E, const int tid, const int* gtab = nullptr) {
    static_assert(!GATHER || SP2, "the gathered A operand is wired into the SP2 loop only");
    const int wid = __builtin_amdgcn_readfirstlane(tid >> 6), lane = tid & 63, wr = wid >> 2, wc = wid & 3, fr = lane & 15, fq = lane >> 4;
    int K_ = g.K; asm volatile("" : "+s"(K_));
    const int K = K_, nt = K / BK;
    unsigned voffA[2], voffB[2];
#pragma unroll
    for (int i = 0; i < 2; ++i) { int R, C; stage_rc(tid * 16 + i * 8192, R, C); const int Rb = Epi::PERM ? ((R & ~31) + perm32(R & 31)) : R;
        voffA[i] = (unsigned)(R * K + C) * 2u; voffB[i] = (unsigned)(Rb * K + C) * 2u; }
    unsigned gc[2][2] = {{0u, 0u}, {0u, 0u}}, gn[2][2] = {{0u, 0u}, {0u, 0u}};
#define PG8_GLOAD(dst, pm_) do { _Pragma("unroll") for (int h_ = 0; h_ < 2; ++h_) _Pragma("unroll") for (int i_ = 0; i_ < 2; ++i_) { int R_, C_; stage_rc(tid * 16 + i_ * 8192, R_, C_); \
        dst[h_][i_] = (unsigned)gtab[(pm_) * BM + h_ * HALF + R_] * (unsigned)(K * 2) + (unsigned)(C_ * 2); } } while (0)
#define PG8_STAGE_A(bufoff, gb_plain, gb_gather, off_g) do { if constexpr (GATHER) { PG8_STAGE(bufoff, gb_gather, off_g); } else { PG8_STAGE(bufoff, gb_plain, voffA); } } while (0)
    const size_t kstep = (size_t)(BK * 2);
    const size_t hstep = (size_t)HALF * K * 2;
    const size_t tstep = 2 * hstep;
    const unsigned ldsw = (unsigned)wid * 1024u;
    const int aoff = lds_byte(wr * 64 + fr, fq * 8), boff = lds_byte(wc * 32 + fr, fq * 8);
#define PG8_SA(b, h) (((b) * 2 + (h)) * HTB)
#define PG8_SB(b, h) ((4 + (b) * 2 + (h)) * HTB)
#define PG8_STAGE(bufoff, gbase, voff) do { _Pragma("unroll") for (int _i = 0; _i < 2; ++_i) \
        __builtin_amdgcn_global_load_lds((const unsigned*)((const char*)(gbase) + (voff)[_i]), (PG8_LAS unsigned*)(lds + (bufoff) + ldsw + _i * 8192), 16, 0, 0); } while (0)
#define PG8_LDA(dst, b, h) do { _Pragma("unroll") for (int m = 0; m < 4; ++m) _Pragma("unroll") for (int k = 0; k < 2; ++k) dst[m][k] = *(const PG8_LAS bf16x8*)(lds + PG8_SA(b, h) + aoff + m * 2048 + k * 1024); } while (0)
#define PG8_LDB(dst, b, h) do { _Pragma("unroll") for (int n = 0; n < 2; ++n) _Pragma("unroll") for (int k = 0; k < 2; ++k) dst[n][k] = *(const PG8_LAS bf16x8*)(lds + PG8_SB(b, h) + boff + n * 2048 + k * 1024); } while (0)
#define PG8_CAT(x) __builtin_shufflevector(__builtin_bit_cast(i32x4, (x)[0]), __builtin_bit_cast(i32x4, (x)[1]), 0, 1, 2, 3, 4, 5, 6, 7)
#define PG8_MMA(ai, bj, At, Bt) do { __builtin_amdgcn_s_setprio(1); if constexpr (F8) { _Pragma("unroll") for (int m = 0; m < 4; ++m) _Pragma("unroll") for (int n = 0; n < 2; ++n) \
        asm volatile("v_mfma_scale_f32_16x16x128_f8f6f4 %0, %1, %2, %0, %3, %3 op_sel_hi:[0,0,0]" : "+v"(acc[ai][bj][m][n]) : "v"(PG8_CAT(Bt[n])), "v"(PG8_CAT(At[m])), "v"(f8sc)); } else { \
        _Pragma("unroll") for (int m = 0; m < 4; ++m) _Pragma("unroll") for (int n = 0; n < 2; ++n) _Pragma("unroll") for (int k = 0; k < 2; ++k) \
        acc[ai][bj][m][n] = __builtin_amdgcn_mfma_f32_16x16x32_bf16(Bt[n][k], At[m][k], acc[ai][bj][m][n], 0, 0, 0); } __builtin_amdgcn_s_setprio(0); } while (0)
#define PG8_WAIT_V(n) asm volatile("s_waitcnt vmcnt(" #n ")" ::: "memory")
#define PG8_WAIT_L(n) asm volatile("s_waitcnt lgkmcnt(" #n ")" ::: "memory")
#define PG8_BAR __builtin_amdgcn_s_barrier()
#define PG8_SCHED __builtin_amdgcn_sched_barrier(0)
    Unit cur, nxt; int ui = 0;
    if (!S.next(0, cur)) return;
    const int f8sc = 0x7f7f7f7f;
    f32x4 acc[2][2][4][2];
#pragma unroll
    for (int a = 0; a < 2; ++a)
#pragma unroll
        for (int b = 0; b < 2; ++b)
#pragma unroll
            for (int m = 0; m < 4; ++m)
#pragma unroll
                for (int n = 0; n < 2; ++n) acc[a][b][m][n] = zero4();
    if constexpr (HasBias<Epi>::value) { typename Epi::BiasRaw pb0_; f32x4 b0_[2][2]; E.bias(cur, wc, fq, pb0_); E.binit(pb0_, b0_);
        _Pragma("unroll") for (int a = 0; a < 2; ++a) _Pragma("unroll") for (int b = 0; b < 2; ++b) _Pragma("unroll") for (int m = 0; m < 4; ++m) _Pragma("unroll") for (int n = 0; n < 2; ++n) acc[a][b][m][n] = b0_[b][n]; }
    bf16x8 At[4][2], B0[2][2], B1[2][2];
    const char* cA = (const char*)g.A + (size_t)cur.pm * tstep; const char* cB = (const char*)g.Bt + (size_t)cur.pn * tstep;
    const char* const gA0 = (const char*)g.A;
    if constexpr (GATHER) { PG8_GLOAD(gc, cur.pm); }

    if constexpr (SP2) {
        PG8_STAGE(PG8_SB(0, 0), cB, voffB); PG8_STAGE(PG8_SB(0, 1), cB + hstep, voffB); PG8_STAGE_A(PG8_SA(0, 0), cA, gA0, gc[0]); PG8_STAGE_A(PG8_SA(0, 1), cA + hstep, gA0, gc[1]);
        if (wr == 1) PG8_BAR;
        PG8_WAIT_V(2); PG8_BAR;
        PG8_STAGE(PG8_SB(1, 0), cB + kstep, voffB); PG8_STAGE_A(PG8_SA(1, 0), cA + kstep, gA0 + kstep, gc[0]); PG8_STAGE(PG8_SB(1, 1), cB + hstep + kstep, voffB);
        PG8_WAIT_V(6); PG8_BAR;
    } else {
        PG8_STAGE(PG8_SB(0, 0), cB, voffB); PG8_STAGE(PG8_SA(0, 0), cA, voffA); PG8_STAGE(PG8_SB(0, 1), cB + hstep, voffB); PG8_STAGE(PG8_SA(0, 1), cA + hstep, voffA);
        if (wr == 1) PG8_BAR;
        PG8_WAIT_V(4); PG8_BAR;
        PG8_STAGE(PG8_SB(1, 0), cB + kstep, voffB); PG8_STAGE(PG8_SA(1, 0), cA + kstep, voffA); PG8_STAGE(PG8_SB(1, 1), cB + hstep + kstep, voffB);
        PG8_WAIT_V(6); PG8_BAR;
    }
    for (;;) {
        const bool has_next = S.next(ui + 1, nxt);
        const char* nA = has_next ? (const char*)g.A + (size_t)nxt.pm * tstep : cA; const char* nB = has_next ? (const char*)g.Bt + (size_t)nxt.pn * tstep : cB;
        if constexpr (GATHER) { if (has_next) { PG8_GLOAD(gn, nxt.pm); } else { _Pragma("unroll") for (int h_ = 0; h_ < 2; ++h_) _Pragma("unroll") for (int i_ = 0; i_ < 2; ++i_) gn[h_][i_] = gc[h_][i_]; } }
        for (int t = 0; t < nt; t += 2) {
            if constexpr (HasMid<Epi>::value) { if (t == (nt >> 1)) E.mid(acc, cur, wr, wc, fr, fq); }
            const bool last = (t == nt - 2);
            const char* a1 = cA + (size_t)(t + 1) * kstep;
            const char* a2 = last ? nA : cA + (size_t)(t + 2) * kstep; const char* b2 = last ? nB : cB + (size_t)(t + 2) * kstep;
            const char* a3 = a2 + kstep; const char* b3 = b2 + kstep;

            if constexpr (SP2) {
            const char* g2 = gA0 + (last ? (size_t)0 : (size_t)(t + 2) * kstep);
            unsigned gs0[2], gs1[2]; gs0[0] = last ? gn[0][0] : gc[0][0]; gs0[1] = last ? gn[0][1] : gc[0][1]; gs1[0] = last ? gn[1][0] : gc[1][0]; gs1[1] = last ? gn[1][1] : gc[1][1];
            PG8_LDB(B0, 0, 0); PG8_LDB(B1, 0, 1); PG8_SCHED; PG8_LDA(At, 0, 0); PG8_STAGE_A(PG8_SA(1, 1), a1 + hstep, gA0 + (size_t)(t + 1) * kstep, gc[1]);
            PG8_WAIT_V(8); PG8_WAIT_L(0); PG8_BAR; PG8_MMA(0, 0, At, B0); PG8_MMA(0, 1, At, B1); PG8_BAR; PG8_SCHED;
            PG8_LDA(At, 0, 1); PG8_STAGE(PG8_SB(0, 0), b2, voffB); PG8_STAGE(PG8_SB(0, 1), b2 + hstep, voffB); PG8_STAGE_A(PG8_SA(0, 0), a2, g2, gs0);
            PG8_WAIT_V(8); PG8_WAIT_L(0); PG8_BAR; PG8_MMA(1, 0, At, B0); PG8_MMA(1, 1, At, B1); PG8_BAR; PG8_SCHED;
            PG8_LDB(B0, 1, 0); PG8_LDB(B1, 1, 1); PG8_SCHED; PG8_LDA(At, 1, 0); PG8_STAGE_A(PG8_SA(0, 1), a2 + hstep, g2, gs1);
            PG8_WAIT_V(8); PG8_WAIT_L(0); PG8_BAR; PG8_MMA(0, 0, At, B0); PG8_MMA(0, 1, At, B1); PG8_BAR; PG8_SCHED;
            PG8_LDA(At, 1, 1); PG8_STAGE(PG8_SB(1, 0), b3, voffB); PG8_STAGE(PG8_SB(1, 1), b3 + hstep, voffB); PG8_STAGE_A(PG8_SA(1, 0), a3, g2 + kstep, gs0);
            PG8_WAIT_V(8); PG8_WAIT_L(0); PG8_BAR; PG8_MMA(1, 0, At, B0); PG8_MMA(1, 1, At, B1); PG8_BAR; PG8_SCHED;
            } else {
            PG8_LDB(B0, 0, 0); PG8_SCHED; PG8_LDA(At, 0, 0); PG8_STAGE(PG8_SA(1, 1), a1 + hstep, voffA);
            PG8_WAIT_L(8); PG8_BAR; PG8_WAIT_L(0); PG8_MMA(0, 0, At, B0); PG8_BAR; PG8_SCHED;
            PG8_LDB(B1, 0, 1); PG8_STAGE(PG8_SB(0, 0), b2, voffB);
            PG8_BAR; PG8_WAIT_L(0); PG8_MMA(0, 1, At, B1); PG8_BAR;
            PG8_LDA(At, 0, 1); PG8_STAGE(PG8_SA(0, 0), a2, voffA);
            PG8_BAR; PG8_WAIT_L(0); PG8_MMA(1, 0, At, B0); PG8_BAR; PG8_SCHED;
            PG8_STAGE(PG8_SB(0, 1), b2 + hstep, voffB);
            PG8_WAIT_V(6); PG8_BAR; PG8_MMA(1, 1, At, B1); PG8_BAR;
            PG8_LDB(B0, 1, 0); PG8_SCHED; PG8_LDA(At, 1, 0); PG8_STAGE(PG8_SA(0, 1), a2 + hstep, voffA);
            PG8_WAIT_L(8); PG8_BAR; PG8_WAIT_L(0); PG8_MMA(0, 0, At, B0); PG8_BAR; PG8_SCHED;
            PG8_LDB(B1, 1, 1); PG8_STAGE(PG8_SB(1, 0), b3, voffB);
            PG8_BAR; PG8_WAIT_L(0); PG8_MMA(0, 1, At, B1); PG8_BAR;
            PG8_LDA(At, 1, 1); PG8_STAGE(PG8_SA(1, 0), a3, voffA);
            PG8_BAR; PG8_WAIT_L(0); PG8_MMA(1, 0, At, B0); PG8_BAR; PG8_SCHED;
            PG8_STAGE(PG8_SB(1, 1), b3 + hstep, voffB);
            PG8_WAIT_V(6); PG8_BAR; PG8_MMA(1, 1, At, B1); PG8_BAR;
            }
        }
        if constexpr (F8) asm volatile("s_nop 15\n\ts_nop 15" ::: "memory");
        if constexpr (ALIGN_EPI) { if (wr == 0) PG8_BAR; }
        typename BiasRawOf<Epi>::type npb_;
        if constexpr (HasBias<Epi>::value) E.epi2(acc, cur, wr, wc, fr, fq, nxt, has_next, npb_);
        else E(acc, cur, wr, wc, fr, fq);
        if (!has_next) break;
        f32x4 nb_[2][2]; if constexpr (HasBias<Epi>::value) E.binit(npb_, nb_);
#pragma unroll
        for (int a = 0; a < 2; ++a)
#pragma unroll
            for (int b = 0; b < 2; ++b)
#pragma unroll
                for (int m = 0; m < 4; ++m)
#pragma unroll
                    for (int n = 0; n < 2; ++n) { if constexpr (HasBias<Epi>::value) acc[a][b][m][n] = copy4(nb_[b][n]); else acc[a][b][m][n] = zero4(); }
        cur = nxt; cA = nA; cB = nB; ++ui;
        if constexpr (GATHER) { _Pragma("unroll") for (int h_ = 0; h_ < 2; ++h_) _Pragma("unroll") for (int i_ = 0; i_ < 2; ++i_) gc[h_][i_] = gn[h_][i_]; }
        if constexpr (ALIGN_EPI) { if (wr == 1) PG8_BAR; }
    }
    PG8_WAIT_V(0);
    if constexpr (!ALIGN_EPI) { if (wr == 0) PG8_BAR; }
    PG8_BAR;

#undef PG8_SA
#undef PG8_SB
#undef PG8_STAGE
#undef PG8_STAGE_A
#undef PG8_GLOAD
#undef PG8_LDA
#undef PG8_LDB
#undef PG8_MMA
#undef PG8_CAT
#undef PG8_WAIT_V
#undef PG8_WAIT_L
#undef PG8_BAR
#undef PG8_SCHED
}
}

#define DI __device__ __forceinline__
#define LAS __attribute__((address_space(3)))
typedef unsigned short bf16;
typedef short bf16x8 __attribute__((ext_vector_type(8)));
typedef short s16x4 __attribute__((ext_vector_type(4)));
typedef float f32x4 __attribute__((ext_vector_type(4)));
typedef float f32x16 __attribute__((ext_vector_type(16)));
typedef unsigned u32x4 __attribute__((ext_vector_type(4)));
typedef unsigned u32x2 __attribute__((ext_vector_type(2)));
typedef float f32x2_t __attribute__((ext_vector_type(2)));
typedef __bf16 bf16x2_t __attribute__((ext_vector_type(2)));

DI float bf2f(unsigned b) { return __uint_as_float(b << 16); }
DI float bflo(unsigned w) { return __uint_as_float(w << 16); }
DI float bfhi(unsigned w) { return __uint_as_float(w & 0xffff0000u); }
DI unsigned pk2(float lo, float hi) { f32x2_t v = {lo, hi}; bf16x2_t b = __builtin_convertvector(v, bf16x2_t); return __builtin_bit_cast(unsigned, b); }
DI float sigmoid_f(float v) { return __builtin_amdgcn_rcpf(1.0f + __builtin_amdgcn_exp2f(-1.4426950408889634f * v)); }
DI u32x4 pack8(f32x4 a, f32x4 b) { u32x4 w; w.x = pk2(a[0], a[1]); w.y = pk2(a[2], a[3]); w.z = pk2(b[0], b[1]); w.w = pk2(b[2], b[3]); return w; }
DI void unpack8(u32x4 w, f32x4& a, f32x4& b) { a = (f32x4){bflo(w.x), bfhi(w.x), bflo(w.y), bfhi(w.y)}; b = (f32x4){bflo(w.z), bfhi(w.z), bflo(w.w), bfhi(w.w)}; }

template <int CTRL> DI float dpp_get(float x) { return __builtin_bit_cast(float, __builtin_amdgcn_update_dpp(0, __builtin_bit_cast(int, x), CTRL, 0xf, 0xf, false)); }
DI float row16_sum(float v) { v += dpp_get<0xB1>(v); v += dpp_get<0x4E>(v); v += dpp_get<0x141>(v); v += dpp_get<0x140>(v); return v; }
DI float row16_max(float v) { v = fmaxf(v, dpp_get<0xB1>(v)); v = fmaxf(v, dpp_get<0x4E>(v)); v = fmaxf(v, dpp_get<0x141>(v)); v = fmaxf(v, dpp_get<0x140>(v)); return v; }
DI float sw16_sum(float v) { const auto rr = __builtin_amdgcn_permlane16_swap(__float_as_uint(v), __float_as_uint(v), false, false); return __uint_as_float(rr[0]) + __uint_as_float(rr[1]); }
DI float sw16_max(float v) { const auto rr = __builtin_amdgcn_permlane16_swap(__float_as_uint(v), __float_as_uint(v), false, false); return fmaxf(__uint_as_float(rr[0]), __uint_as_float(rr[1])); }
DI float sw32_sum(float v) { const auto rr = __builtin_amdgcn_permlane32_swap(__float_as_uint(v), __float_as_uint(v), false, false); return __uint_as_float(rr[0]) + __uint_as_float(rr[1]); }
DI float sw32_max(float v) { const auto rr = __builtin_amdgcn_permlane32_swap(__float_as_uint(v), __float_as_uint(v), false, false); return fmaxf(__uint_as_float(rr[0]), __uint_as_float(rr[1])); }

constexpr int BATCH = 8, SEQ = 4096, DM = 1024, NTOK = BATCH * SEQ;
constexpr int PN = 7936;
constexpr int DQ_OFF = 0, DK_OFF = 1024, DV_OFF = 2048, NQ_OFF = 3072, KC_OFF = 4096, VC_OFF = 4352, KS_OFF = 4608, VS_OFF = 4864, KW_OFF = 5120, VW_OFF = 5376, NG_OFF = 5632, MG_OFF = 5888;
constexpr int CIN = 5680;
constexpr float LOG2E = 1.4426950408889634f;
constexpr float QSCALE = 0.125f * LOG2E;
constexpr float LN_EPS = 1e-5f;
constexpr float DN_ALPHA = 1.189207115002721f;
constexpr float LAMBDA_INIT = 0.2f;
constexpr int NEXP = 32, TOPK = 4, DFF = 1024;
constexpr int MAXBLK = (NTOK * TOPK) / 256 + NEXP;
constexpr int MAXSLOT = MAXBLK * 256;
constexpr float ODSCALE = 4.0f, ONSCALE = 8.0f;
constexpr float YSCALE = 64.0f;
constexpr float W2SCALE = 64.0f, ACTSCALE = 4.0f;
constexpr float W1SCALE = 64.0f;
DI unsigned pack4_fp8(float a, float b, float c, float d) { int w = __builtin_amdgcn_cvt_pk_fp8_f32(a, b, 0, false); w = __builtin_amdgcn_cvt_pk_fp8_f32(c, d, w, true); return (unsigned)w; }

#define EPI_ARGS const pg8::f32x4 (&acc)[2][2][4][2], const pg8::Unit& u, int wr, int wc, int fr, int fq
#define EPI_PIN asm volatile("" : "+v"(fr), "+v"(fq));
#define EPI_ROWS _Pragma("unroll") for (int ai = 0; ai < 2; ++ai) _Pragma("unroll") for (int m = 0; m < 4; ++m)
#define EPI_ROW (u.pm * 256 + ai * 128 + wr * 64 + m * 16 + fr)

template <bool F8> struct EpiProjT {
    static constexpr bool PERM = true; static constexpr float ASC = F8 ? (1.0f / W1SCALE) : 1.0f;
    bf16* O; const float* bias; int pn0; int* kn2;
    DI void operator()(EPI_ARGS) const { EPI_PIN
        const int pn = u.pn + pn0; const int colt = pn * 256; const int mode = (pn < 4 || (pn >= 12 && pn < 16)) ? 1 : (pn >= 22 ? 2 : 0);
        const int cl = wc * 32 + 8 * fq;
        f32x4 bv[2][2];
#pragma unroll
        for (int bj = 0; bj < 2; ++bj)
#pragma unroll
            for (int n = 0; n < 2; ++n) bv[bj][n] = *(const f32x4*)(bias + colt + bj * 128 + cl + 4 * n);
        float kmx[2] = {0.f, 0.f};
        EPI_ROWS { bf16* rowp = O + (size_t)EPI_ROW * PN + colt + cl;
#pragma unroll
            for (int bj = 0; bj < 2; ++bj) { f32x4 v0 = acc[ai][bj][m][0] * ASC + bv[bj][0], v1 = acc[ai][bj][m][1] * ASC + bv[bj][1];
                if constexpr (!F8) { if (pn >= 4 && pn < 8) {
                    const u32x4 w = pack8(v0, v1); float s2 = 0.f;
#pragma unroll
                    for (int j = 0; j < 4; ++j) { const float a = bflo(w[j]), c2 = bfhi(w[j]); s2 += a * a + c2 * c2; }
                    s2 = sw16_sum(s2); s2 = sw32_sum(s2); kmx[bj] = fmaxf(kmx[bj], s2); } }
                if (mode == 1) { v0 = v0 * QSCALE; v1 = v1 * QSCALE; }
                if (mode == 2) {
#pragma unroll
                    for (int i = 0; i < 4; ++i) { v0[i] = sigmoid_f(v0[i]); v1[i] = sigmoid_f(v1[i]); } }
                __builtin_nontemporal_store(pack8(v0, v1), (u32x4*)(rowp + bj * 128)); } }
        if constexpr (!F8) { if (pn >= 4 && pn < 8) {
#pragma unroll
            for (int bj = 0; bj < 2; ++bj) { float v = kmx[bj];
#pragma unroll
                for (int o_ = 0; o_ < 1; ++o_) v = row16_max(v);
                if (fr == 0 && fq == 0) __hip_atomic_fetch_max(kn2 + (((u.pm >> 4) * 16 + ((pn - 4) * 2 + bj) * 2 + (wc >> 1)) * 2 + (wc & 1)), __builtin_bit_cast(int, v), __ATOMIC_RELAXED, __HIP_MEMORY_SCOPE_AGENT); } } }
    }
};
template <int ACT, bool NT = false> struct EpiBf16 {
    static constexpr bool PERM = true;
    bf16* O; int ldc; int local_pn;
    DI void operator()(EPI_ARGS) const { EPI_PIN
        const int colt = local_pn ? 0 : u.pn * 256; const int cl = wc * 32 + 8 * fq;
        EPI_ROWS { bf16* rowp = O + (size_t)EPI_ROW * ldc + colt + cl;
#pragma unroll
            for (int bj = 0; bj < 2; ++bj) { f32x4 v0 = acc[ai][bj][m][0], v1 = acc[ai][bj][m][1];
                if (ACT == 1) {
#pragma unroll
                    for (int i = 0; i < 4; ++i) { v0[i] = v0[i] * sigmoid_f(v0[i]); v1[i] = v1[i] * sigmoid_f(v1[i]); } }
                if (NT) __builtin_nontemporal_store(pack8(v0, v1), (u32x4*)(rowp + bj * 128)); else *(u32x4*)(rowp + bj * 128) = pack8(v0, v1); } }
    }
};
struct EpiBrM {
    static constexpr bool PERM = true, MIDK = true; static constexpr float ASC1 = 1.0f / (W1SCALE * ODSCALE), ASC2 = 1.0f / (W1SCALE * ONSCALE);
    const bf16* proj; bf16* MX;
    DI void mid(pg8::f32x4 (&acc)[2][2][4][2], const pg8::Unit& u, int wr, int wc, int fr, int fq) const { EPI_PIN
        const int cl = u.pn * 256 + wc * 32 + 8 * fq;
        EPI_ROWS { const size_t row = EPI_ROW;
#pragma unroll
            for (int bj = 0; bj < 2; ++bj) { const int col = cl + bj * 128;
                const u32x4 ga = __builtin_nontemporal_load((const u32x4*)(proj + row * PN + MG_OFF + col)), gb = *(const u32x4*)(proj + row * PN + MG_OFF + DM + col);
                f32x4 a0, a1, b0, b1; unpack8(ga, a0, a1); unpack8(gb, b0, b1);
#pragma unroll
                for (int i = 0; i < 4; ++i) { a0[i] = a0[i] * (ASC1 / ASC2) * __builtin_amdgcn_rcpf(fmaxf(b0[i], 1e-30f)); a1[i] = a1[i] * (ASC1 / ASC2) * __builtin_amdgcn_rcpf(fmaxf(b1[i], 1e-30f)); }
                acc[ai][bj][m][0] = acc[ai][bj][m][0] * a0; acc[ai][bj][m][1] = acc[ai][bj][m][1] * a1; } }
    }
    DI void operator()(EPI_ARGS) const { EPI_PIN
        const int cl = u.pn * 256 + wc * 32 + 8 * fq;
        EPI_ROWS { const size_t row = EPI_ROW;
#pragma unroll
            for (int bj = 0; bj < 2; ++bj) { const int col = cl + bj * 128;
                const u32x4 g = __builtin_nontemporal_load((const u32x4*)(proj + row * PN + MG_OFF + DM + col)); f32x4 g0, g1; unpack8(g, g0, g1);
                *(u32x4*)(MX + row * DM + col) = pack8(acc[ai][bj][m][0] * (g0 * ASC2), acc[ai][bj][m][1] * (g1 * ASC2)); } }
    }
};
struct EpiHpre {
    static constexpr bool PERM = true;
    const float* X; bf16* H;
    DI void operator()(EPI_ARGS) const { EPI_PIN
        const int cl = u.pn * 256 + wc * 32 + 8 * fq;
        EPI_ROWS { const size_t row = EPI_ROW;
#pragma unroll
            for (int bj = 0; bj < 2; ++bj) { const size_t off = row * DM + cl + bj * 128;
                const f32x4 x0 = __builtin_nontemporal_load((const f32x4*)(X + off)), x1 = __builtin_nontemporal_load((const f32x4*)(X + off + 4));
                *(u32x4*)(H + off) = pack8(x0 * DN_ALPHA + acc[ai][bj][m][0], x1 * DN_ALPHA + acc[ai][bj][m][1]); } }
    }
};
template <bool F8> struct EpiPleT {
    static constexpr bool PERM = true; static constexpr float ASC = F8 ? (1.0f / W1SCALE) : 1.0f;
    bf16* T2; const float* bias;
    DI void operator()(EPI_ARGS) const { EPI_PIN
        const int cl = u.pn * 256 + wc * 32 + 8 * fq;
        f32x4 bv[2][2];
#pragma unroll
        for (int bj = 0; bj < 2; ++bj)
#pragma unroll
            for (int n = 0; n < 2; ++n) bv[bj][n] = *(const f32x4*)(bias + cl + bj * 128 + 4 * n);
        EPI_ROWS { const size_t row = EPI_ROW;
#pragma unroll
            for (int bj = 0; bj < 2; ++bj) { bf16* tp = T2 + row * DM + cl + bj * 128;
                const u32x4 t = __builtin_nontemporal_load((const u32x4*)tp); f32x4 t0, t1; unpack8(t, t0, t1);
                f32x4 v0 = acc[ai][bj][m][0] * ASC + bv[bj][0], v1 = acc[ai][bj][m][1] * ASC + bv[bj][1];
#pragma unroll
                for (int i = 0; i < 4; ++i) { v0[i] = sigmoid_f(v0[i]) * t0[i]; v1[i] = sigmoid_f(v1[i]) * t1[i]; }
                *(u32x4*)tp = pack8(v0, v1); } }
    }
};
template <bool F8> struct EpiFfn1T {
    static constexpr bool PERM = true; static constexpr float ASC = F8 ? (1.0f / W1SCALE) : 1.0f, LS = F8 ? ACTSCALE : 1.0f;
    bf16* ACT; const bf16* b1h;
    static constexpr bool BIASINIT = true; struct BiasRaw { u32x4 v[2]; };
    DI void bias(const pg8::Unit& u, int wc, int fq, BiasRaw& raw) const { asm volatile("" : "+v"(fq));
        const int e = u.pn >> 3, pnl = u.pn & 7; const bf16* bp = b1h + (size_t)e * 2 * DFF + pnl * 128 + wc * 32 + 8 * fq;
        raw.v[0] = *(const u32x4*)bp; raw.v[1] = *(const u32x4*)(bp + DFF); }
    DI void binit(const BiasRaw& raw, pg8::f32x4 (&b)[2][2]) const { f32x4 t0, t1;
        unpack8(raw.v[0], t0, t1); b[0][0] = t0 * (1.0f / ASC); b[0][1] = t1 * (1.0f / ASC);
        unpack8(raw.v[1], t0, t1); b[1][0] = (t0 + 1.0f) * (1.0f / ASC); b[1][1] = (t1 + 1.0f) * (1.0f / ASC); }
    template <int AI> DI void rows(const pg8::f32x4 (&acc)[2][2][4][2], const pg8::Unit& u, int wr, int wc, int fr, int fq) const {
        constexpr int ai = AI; const int pnl = u.pn & 7; const int cl = pnl * 128 + wc * 32 + 8 * fq;
#pragma unroll
        for (int m = 0; m < 4; ++m) { const size_t row = EPI_ROW;
            f32x4 g0 = acc[ai][0][m][0] * ASC, g1 = acc[ai][0][m][1] * ASC, l0 = acc[ai][1][m][0] * (ASC * LS), l1 = acc[ai][1][m][1] * (ASC * LS);
#define SWIGLU2(G, L, i_) do { const f32x2_t a2 = (f32x2_t){fminf(G[i_], 7.0f), fminf(G[(i_) + 1], 7.0f)}; \
                const f32x2_t b2 = (f32x2_t){__builtin_amdgcn_fmed3f(L[i_], -6.0f * LS, 8.0f * LS), __builtin_amdgcn_fmed3f(L[(i_) + 1], -6.0f * LS, 8.0f * LS)}; \
                const f32x2_t t2 = a2 * (-1.702f * 1.4426950408889634f); f32x2_t d2 = (f32x2_t){__builtin_amdgcn_exp2f(t2.x), __builtin_amdgcn_exp2f(t2.y)} + 1.0f; \
                const f32x2_t r2 = (f32x2_t){__builtin_amdgcn_rcpf(d2.x), __builtin_amdgcn_rcpf(d2.y)}; const f32x2_t o2 = (a2 * r2) * b2; G[i_] = o2.x; G[(i_) + 1] = o2.y; } while (0)
            SWIGLU2(g0, l0, 0); SWIGLU2(g0, l0, 2); SWIGLU2(g1, l1, 0); SWIGLU2(g1, l1, 2);
#undef SWIGLU2
            if constexpr (F8) { u32x2 o8; o8.x = pack4_fp8(g0[0], g0[1], g0[2], g0[3]); o8.y = pack4_fp8(g1[0], g1[1], g1[2], g1[3]); *(u32x2*)((unsigned char*)ACT + row * DFF + cl) = o8; }
            else *(u32x4*)(ACT + row * DFF + cl) = pack8(g0, g1); }
    }
    DI void epi2(const pg8::f32x4 (&acc)[2][2][4][2], const pg8::Unit& u, int wr, int wc, int fr, int fq, const pg8::Unit& nx, bool has_next, BiasRaw& raw) const { EPI_PIN
        rows<0>(acc, u, wr, wc, fr, fq);
        __builtin_amdgcn_sched_barrier(0);
        if (has_next) bias(nx, wc, fq, raw);
        __builtin_amdgcn_sched_barrier(0);
        rows<1>(acc, u, wr, wc, fr, fq);
    }
    DI void operator()(EPI_ARGS) const { EPI_PIN rows<0>(acc, u, wr, wc, fr, fq); rows<1>(acc, u, wr, wc, fr, fq); }
};
template <bool F8> struct EpiFfn2T {
    static constexpr bool PERM = true; static constexpr float ASC = F8 ? 1.0f / (W2SCALE * ACTSCALE) : 1.0f;
    bf16* Y; const bf16* b2h;
    static constexpr bool BIASINIT = true; struct BiasRaw { u32x4 v[2]; };
    DI void bias(const pg8::Unit& u, int wc, int fq, BiasRaw& raw) const { asm volatile("" : "+v"(fq));
        const int e = u.pn >> 2, pnl = u.pn & 3; const bf16* bp = b2h + (size_t)e * DM + pnl * 256 + wc * 32 + 8 * fq;
        raw.v[0] = *(const u32x4*)bp; raw.v[1] = *(const u32x4*)(bp + 128); }
    DI void binit(const BiasRaw& raw, pg8::f32x4 (&b)[2][2]) const { f32x4 t0, t1;
        unpack8(raw.v[0], t0, t1); b[0][0] = t0 * (1.0f / ASC); b[0][1] = t1 * (1.0f / ASC);
        unpack8(raw.v[1], t0, t1); b[1][0] = t0 * (1.0f / ASC); b[1][1] = t1 * (1.0f / ASC); }
    template <int AI> DI void rows(const pg8::f32x4 (&acc)[2][2][4][2], const pg8::Unit& u, int wr, int wc, int fr, int fq) const {
        constexpr int ai = AI; const int pnl = u.pn & 3; const int cl = pnl * 256 + wc * 32 + 8 * fq;
#pragma unroll
        for (int m = 0; m < 4; ++m) { const size_t row = EPI_ROW; const float gs = ASC * (F8 ? YSCALE : 1.0f);
#pragma unroll
            for (int bj = 0; bj < 2; ++bj) { const f32x4 y0 = acc[ai][bj][m][0] * gs, y1 = acc[ai][bj][m][1] * gs;
                if constexpr (F8) { u32x2 o8; o8.x = pack4_fp8(y0[0], y0[1], y0[2], y0[3]); o8.y = pack4_fp8(y1[0], y1[1], y1[2], y1[3]); *(u32x2*)((unsigned char*)Y + row * DM + cl + bj * 128) = o8; }
                else *(u32x4*)(Y + row * DM + cl + bj * 128) = pack8(y0, y1); } }
    }
    DI void epi2(const pg8::f32x4 (&acc)[2][2][4][2], const pg8::Unit& u, int wr, int wc, int fr, int fq, const pg8::Unit& nx, bool has_next, BiasRaw& raw) const { EPI_PIN
        rows<0>(acc, u, wr, wc, fr, fq);
        __builtin_amdgcn_sched_barrier(0);
        if (has_next) bias(nx, wc, fq, raw);
        __builtin_amdgcn_sched_barrier(0);
        rows<1>(acc, u, wr, wc, fr, fq);
    }
};

struct OneUnit { int pm, pn; DI bool next(int i, pg8::Unit& u) const { if (i > 0) return false; u.pm = pm; u.pn = pn; return true; } };
struct ListOrder {
    int n, per, G, c;
    DI bool next(int i, pg8::Unit& u) const { const int L = i * G + c; if (L >= n) return false; u.pm = L; u.pn = L / per; return true; }
};
struct TailOrder {
    int n, nN, G, c;
    DI bool next(int i, pg8::Unit& u) const { if (c < 0) return false; const int L = i * G + c; if (L >= n) return false; u.pm = L / nN; u.pn = L % nN; return true; }
};
struct FillOrder {
    int n, nN, G, c, c0, base;
    DI bool next(int i, pg8::Unit& u) const { const int nf = c0 ? G - c0 : 0; int p;
        if (c0 && c >= c0) p = (i == 0) ? c - c0 : nf + (i - 1) * G + c; else p = nf + i * G + c;
        if (p >= n) return false; p += base; u.pm = p / nN; u.pn = p % nN; return true; }
};
struct GroupedOrder {
    const int* blk_e; int nblk, NT, G, c;
    int gap_e, gap_pn;
    DI bool next(int i, pg8::Unit& u) const { const long L = (long)i * G + c; if (L >= (long)nblk * NT) return false; const int pm = (int)(L / NT), pnl = (int)(L % NT);
        const int e = __builtin_amdgcn_readfirstlane(blk_e[pm]); u.pm = pm; u.pn = e * NT + pnl + (e >= gap_e ? gap_pn : 0); return true; }
};

#define MFMA32(a, b, c) __builtin_amdgcn_mfma_f32_32x32x16_bf16((a), (b), (c), 0, 0, 0)
#define KR(r) (((r) & 3) + 8 * ((r) >> 2))
constexpr int KSTR = 144, VSTR64 = 192, VSTR128 = 320;
#define NEG_INF (-__builtin_inff())
typedef short v4i16_t __attribute__((ext_vector_type(4)));
DI s16x4 vtr(LAS const unsigned char* p) { return __builtin_bit_cast(s16x4, __builtin_amdgcn_ds_read_tr16_b64_v4i16((LAS v4i16_t*)p)); }
DI bf16x8 packp(const f32x16& p, int s8) { u32x4 w; w.x = pk2(p[s8], p[s8 + 1]); w.y = pk2(p[s8 + 2], p[s8 + 3]); w.z = pk2(p[s8 + 4], p[s8 + 5]); w.w = pk2(p[s8 + 6], p[s8 + 7]); return __builtin_bit_cast(bf16x8, w); }

DI void qk_tile(f32x16& p0, f32x16& p1, LAS const unsigned char* Kt, const bf16x8 (&qf)[4], int r32, int hi) {
    LAS const unsigned char* kb = Kt + r32 * KSTR + hi * 16;
    f32x16 z;
#pragma unroll
    for (int i = 0; i < 16; ++i) z[i] = 0.f;
    p0 = z; p1 = z;
#pragma unroll
    for (int s = 0; s < 4; ++s) {
        const bf16x8 a0 = *(LAS const bf16x8*)(kb + s * 32), a1 = *(LAS const bf16x8*)(kb + 32 * KSTR + s * 32);
        p0 = MFMA32(a0, qf[s], p0); p1 = MFMA32(a1, qf[s], p1); }
}
DI void qk_tile_c(f32x16& p0, f32x16& p1, LAS const unsigned char* Kt, const bf16x8 (&qf)[4], int r32, int hi, const f32x16& cK) {
    LAS const unsigned char* kb = Kt + r32 * KSTR + hi * 16;
    p0 = cK; p1 = cK;
#pragma unroll
    for (int s = 0; s < 4; ++s) {
        const bf16x8 a0 = *(LAS const bf16x8*)(kb + s * 32), a1 = *(LAS const bf16x8*)(kb + 32 * KSTR + s * 32);
        p0 = MFMA32(a0, qf[s], p0); p1 = MFMA32(a1, qf[s], p1); }
}
DI void mask_only(f32x16& p0, f32x16& p1, float dn0, float ksf, float lo, float hi_) {
#pragma unroll
    for (int r = 0; r < 16; ++r) { const float d0 = dn0 + ksf * (float)KR(r), d1 = d0 + 32.0f * ksf;
        p0[r] = (d0 >= lo && d0 <= hi_) ? p0[r] : NEG_INF; p1[r] = (d1 >= lo && d1 <= hi_) ? p1[r] : NEG_INF; }
}
template <int DVB, int VS> DI void pv_tile(f32x16 (&o)[DVB], LAS const unsigned char* Vt, const bf16x8 (&pf)[4], int lane) {
    const int hi = lane >> 5;
    LAS const unsigned char* vb = Vt + (4 * hi + ((lane & 15) >> 2)) * VS + (16 * ((lane >> 4) & 1) + 4 * (lane & 3)) * 2;
#pragma unroll
    for (int db = 0; db < DVB; ++db)
#pragma unroll
        for (int bs = 0; bs < 4; ++bs) {
            const s16x4 lo = vtr(vb + (16 * bs) * VS + db * 64), hh = vtr(vb + (16 * bs + 8) * VS + db * 64);
            const bf16x8 a = __builtin_shufflevector(lo, hh, 0, 1, 2, 3, 4, 5, 6, 7);
            o[db] = MFMA32(a, pf[bs], o[db]); }
}
template <int DVB, int VS> DI void pv_load(bf16x8 (&vf)[DVB][4], LAS const unsigned char* Vt, int lane) {
    const int hi = lane >> 5;
    LAS const unsigned char* vb = Vt + (4 * hi + ((lane & 15) >> 2)) * VS + (16 * ((lane >> 4) & 1) + 4 * (lane & 3)) * 2;
#pragma unroll
    for (int db = 0; db < DVB; ++db)
#pragma unroll
        for (int bs = 0; bs < 4; ++bs) { const s16x4 lo = vtr(vb + (16 * bs) * VS + db * 64), hh = vtr(vb + (16 * bs + 8) * VS + db * 64); vf[db][bs] = __builtin_shufflevector(lo, hh, 0, 1, 2, 3, 4, 5, 6, 7); }
}
template <int DVB> DI void pv_mma(f32x16 (&o)[DVB], const bf16x8 (&vf)[DVB][4], const bf16x8 (&pf)[4]) {
#pragma unroll
    for (int db = 0; db < DVB; ++db)
#pragma unroll
        for (int bs = 0; bs < 4; ++bs) o[db] = MFMA32(vf[db][bs], pf[bs], o[db]);
}
template <bool MASKED> DI void bias_mask(f32x16& p0, f32x16& p1, float slope_s, float dn0, float ksf, float lo, float hi_) {
#pragma unroll
    for (int r = 0; r < 16; ++r) { p0[r] = __builtin_fmaf(slope_s, (float)KR(r), p0[r]); p1[r] = __builtin_fmaf(slope_s, (float)KR(r), p1[r]); }
    if (MASKED) {
#pragma unroll
        for (int r = 0; r < 16; ++r) { const float d0 = dn0 + ksf * (float)KR(r), d1 = d0 + 32.0f * ksf;
            p0[r] = (d0 >= lo && d0 <= hi_) ? p0[r] : NEG_INF; p1[r] = (d1 >= lo && d1 <= hi_) ? p1[r] : NEG_INF; }
    }
}
DI float xmax32(float x) { const auto rr = __builtin_amdgcn_permlane32_swap(__float_as_uint(x), __float_as_uint(x), false, false); return fmaxf(__uint_as_float(rr[0]), __uint_as_float(rr[1])); }
DI float xsum32(float x) { const auto rr = __builtin_amdgcn_permlane32_swap(__float_as_uint(x), __float_as_uint(x), false, false); return __uint_as_float(rr[0]) + __uint_as_float(rr[1]); }
DI u32x4 widen16(const unsigned (&wq)[4]) {
    const auto r0 = __builtin_amdgcn_permlane32_swap(wq[0], wq[1], false, false), r1 = __builtin_amdgcn_permlane32_swap(wq[2], wq[3], false, false);
    const auto s0 = __builtin_amdgcn_permlane32_swap(r0[0], r1[0], false, false), s1 = __builtin_amdgcn_permlane32_swap(r0[1], r1[1], false, false);
    u32x4 ov; ov.x = s0[0]; ov.y = s1[0]; ov.z = s0[1]; ov.w = s1[1]; return ov;
}
DI float max16(const f32x16& p) { float a = fmaxf(p[0], p[1]), b = fmaxf(p[2], p[3]);
#pragma unroll
    for (int r = 4; r < 16; r += 2) { a = fmaxf(a, p[r]); b = fmaxf(b, p[r + 1]); } return fmaxf(a, b); }
template <int DVB> DI bool softmax_online(f32x16& p0, f32x16& p1, float base0, float base1, float& m, float& l, f32x16 (&o)[DVB], bf16x8 (&pf)[4]) {
    float mx = fmaxf(max16(p0) + base0, max16(p1) + base1); mx = xmax32(mx);
    const bool grow = __any(mx > m) != 0;
    if (!grow && __all(mx < m - 150.0f)) return false;
    const float mn = fmaxf(m, mx), alpha = __builtin_amdgcn_exp2f(m - mn), e0 = base0 - mn, e1 = base1 - mn;
    float s0 = 0.f, s1 = 0.f;
#pragma unroll
    for (int r = 0; r < 16; ++r) { p0[r] = __builtin_amdgcn_exp2f(p0[r] + e0); p1[r] = __builtin_amdgcn_exp2f(p1[r] + e1); s0 += p0[r]; s1 += p1[r]; }
    float s = s0 + s1; s = xsum32(s);
    l = l * alpha + s; m = mn;
    if (grow) {
#pragma unroll
        for (int db = 0; db < DVB; ++db)
#pragma unroll
            for (int r = 0; r < 16; ++r) o[db][r] *= alpha;
    }
    pf[0] = packp(p0, 0); pf[1] = packp(p0, 8); pf[2] = packp(p1, 0); pf[3] = packp(p1, 8);
    return true;
}
template <int DVB> DI void softmax_pv(f32x16& p0, f32x16& p1, float base0, float base1, float& m, float& l, f32x16 (&o)[DVB], const bf16x8 (&vf)[DVB][4]) {
    float mx = fmaxf(max16(p0) + base0, max16(p1) + base1); mx = xmax32(mx);
    const bool grow = __any(mx > m) != 0;
    if (!grow && __all(mx < m - 150.0f)) return;
    const float mn = fmaxf(m, mx), alpha = __builtin_amdgcn_exp2f(m - mn), e0 = base0 - mn, e1 = base1 - mn;
    if (grow) {
#pragma unroll
        for (int db = 0; db < DVB; ++db)
#pragma unroll
            for (int r = 0; r < 16; ++r) o[db][r] *= alpha;
    }
    float s0 = 0.f, s1 = 0.f;
#pragma unroll
    for (int r = 0; r < 16; ++r) { p0[r] = __builtin_amdgcn_exp2f(p0[r] + e0); s0 += p0[r]; }
    { const bf16x8 pa = packp(p0, 0), pb = packp(p0, 8);
#pragma unroll
      for (int db = 0; db < DVB; ++db) { o[db] = MFMA32(vf[db][0], pa, o[db]); o[db] = MFMA32(vf[db][1], pb, o[db]); } }
#pragma unroll
    for (int r = 0; r < 16; ++r) { p1[r] = __builtin_amdgcn_exp2f(p1[r] + e1); s1 += p1[r]; }
    { const bf16x8 pa = packp(p1, 0), pb = packp(p1, 8);
#pragma unroll
      for (int db = 0; db < DVB; ++db) { o[db] = MFMA32(vf[db][2], pa, o[db]); o[db] = MFMA32(vf[db][3], pb, o[db]); } }
    float s = s0 + s1; s = xsum32(s);
    l = l * alpha + s; m = mn;
}
DI void softmax_stats(const f32x16& p0, const f32x16& p1, float base0, float base1, float& m, float& l) {
    float mx = fmaxf(max16(p0) + base0, max16(p1) + base1); mx = xmax32(mx);
    const float mn = fmaxf(m, mx), alpha = __builtin_amdgcn_exp2f(m - mn), e0 = base0 - mn, e1 = base1 - mn;
    float s0 = 0.f, s1 = 0.f;
#pragma unroll
    for (int r = 0; r < 16; ++r) { s0 += __builtin_amdgcn_exp2f(p0[r] + e0); s1 += __builtin_amdgcn_exp2f(p1[r] + e1); }
    float s = s0 + s1; s = xsum32(s);
    l = l * alpha + s; m = mn;
}
DI void softmax_fixed(f32x16& p0, f32x16& p1, float base0, float base1, float m, bf16x8 (&pf)[4]) {
    const float e0 = base0 - m, e1 = base1 - m;
#pragma unroll
    for (int r = 0; r < 16; ++r) { p0[r] = __builtin_amdgcn_exp2f(p0[r] + e0); p1[r] = __builtin_amdgcn_exp2f(p1[r] + e1); }
    pf[0] = packp(p0, 0); pf[1] = packp(p0, 8); pf[2] = packp(p1, 0); pf[3] = packp(p1, 8);
}

#define STREAM_LOOP2(JFIRST, NEXTJ, LOADA, LOADB, WRITEA, WRITEB, COMPT) do { int j0_ = (JFIRST); if (j0_ >= 0) { int j1_ = NEXTJ(j0_); LOADA(j0_); LOADB((j1_ >= 0 ? j1_ : j0_)); \
    WRITEA(0); __syncthreads(); \
    for (;;) { const int j2_ = (j1_ >= 0) ? NEXTJ(j1_) : -1; LOADA((j2_ >= 0 ? j2_ : j0_)); COMPT(j0_, 0); if (j1_ >= 0) { WRITEB(1); } __syncthreads(); if (j1_ < 0) break; \
               const int j3_ = (j2_ >= 0) ? NEXTJ(j2_) : -1; LOADB((j3_ >= 0 ? j3_ : j1_)); COMPT(j1_, 1); if (j2_ >= 0) { WRITEA(0); } __syncthreads(); if (j2_ < 0) break; j0_ = j2_; j1_ = j3_; } } } while (0)

template <int DVB, int VS, bool MASKED> DI void sm_pv_step(f32x16& p0, f32x16& p1, float slope_s, float dn0, float ksf, float lo, float hi_, float base0, float base1,
                                                            float& m, float& l, f32x16 (&o)[DVB], bf16x8 (&pfo)[4], LAS const unsigned char* Vp, int lane) {
    const int hi = lane >> 5;
    LAS const unsigned char* vb = Vp + (4 * hi + ((lane & 15) >> 2)) * VS + (16 * ((lane >> 4) & 1) + 4 * (lane & 3)) * 2;
#define PVG(bs) _Pragma("unroll") for (int db = 0; db < DVB; ++db) { const s16x4 lo_ = vtr(vb + (16 * (bs)) * VS + db * 64), hh_ = vtr(vb + (16 * (bs) + 8) * VS + db * 64); \
        o[db] = MFMA32(__builtin_shufflevector(lo_, hh_, 0, 1, 2, 3, 4, 5, 6, 7), pfo[bs], o[db]); }
    PVG(0) PVG(1)
    bias_mask<MASKED>(p0, p1, slope_s, dn0, ksf, lo, hi_);
    float mx = fmaxf(max16(p0) + base0, max16(p1) + base1); mx = xmax32(mx);
    const bool grow = __any(mx > m) != 0;
    const float mn = fmaxf(m, mx), alpha = __builtin_amdgcn_exp2f(m - mn), e0 = base0 - mn, e1 = base1 - mn;
    PVG(2)
    float s0 = 0.f, s1 = 0.f;
#pragma unroll
    for (int r = 0; r < 16; ++r) { p0[r] = __builtin_amdgcn_exp2f(p0[r] + e0); s0 += p0[r]; }
    PVG(3)
#pragma unroll
    for (int r = 0; r < 16; ++r) { p1[r] = __builtin_amdgcn_exp2f(p1[r] + e1); s1 += p1[r]; }
#undef PVG
    float s = s0 + s1; s = xsum32(s);
    l = l * alpha + s; m = mn;
    if (grow) {
#pragma unroll
        for (int db = 0; db < DVB; ++db)
#pragma unroll
            for (int r = 0; r < 16; ++r) o[db][r] *= alpha;
    }
    pfo[0] = packp(p0, 0); pfo[1] = packp(p0, 8); pfo[2] = packp(p1, 0); pfo[3] = packp(p1, 8);
}
#define STREAM_LOOP3(JFIRST, NEXTJ, LOADA, LOADB, WRITEA, WRITEB, STEPT, FINALT) do { int j0_ = (JFIRST); if (j0_ >= 0) { int j1_ = NEXTJ(j0_); LOADA(j0_); LOADB((j1_ >= 0 ? j1_ : j0_)); \
    WRITEA(0); __syncthreads(); int bc_ = 0, bp_ = 0; \
    for (;;) { const int j2_ = (j1_ >= 0) ? NEXTJ(j1_) : -1; LOADA((j2_ >= 0 ? j2_ : j0_)); STEPT(j0_, bc_, bp_); { const int bn_ = bc_ == 2 ? 0 : bc_ + 1; if (j1_ >= 0) { WRITEB(bn_); } __syncthreads(); bp_ = bc_; if (j1_ < 0) break; bc_ = bn_; } \
               const int j3_ = (j2_ >= 0) ? NEXTJ(j2_) : -1; LOADB((j3_ >= 0 ? j3_ : j1_)); STEPT(j1_, bc_, bp_); { const int bn_ = bc_ == 2 ? 0 : bc_ + 1; if (j2_ >= 0) { WRITEA(bn_); } __syncthreads(); bp_ = bc_; if (j2_ < 0) break; bc_ = bn_; } j0_ = j2_; j1_ = j3_; } \
    FINALT(bp_); __syncthreads(); } } while (0)

struct DiffArgs { const bf16* proj; bf16* odiff; const float* subln; const float* lam; const int* kn2; };
constexpr int DIFF_STG = 2 * 64 * KSTR + 64 * VSTR128;
DI void diff_unit(const DiffArgs& A, int b, int h, int qb, LAS unsigned char* lds, int tid) {
    asm volatile("" : "+v"(tid));
    const int lane = tid & 63, w = __builtin_amdgcn_readfirstlane(tid >> 6), r32 = lane & 31, hi = lane >> 5;
    const int comp = w >> 2, qs = w & 3, q0w = qb * 128 + qs * 32, tq = q0w + r32;
    const size_t rowbase = (size_t)b * SEQ;
    const float slope2 = __builtin_amdgcn_exp2f(-(float)(h + 1)) * LOG2E;
    bf16x8 qf[4];
    { const bf16* qp = A.proj + (rowbase + tq) * PN + DQ_OFF + h * 128 + comp * 64 + hi * 8;
#pragma unroll
      for (int s = 0; s < 4; ++s) qf[s] = *(const bf16x8*)(qp + 16 * s); }
    f32x16 o[4];
#pragma unroll
    for (int d = 0; d < 4; ++d)
#pragma unroll
        for (int r = 0; r < 16; ++r) o[d][r] = 0.f;
    float m = -1e30f, l = 0.f;
    const int NT = 2 * qb + 2;
    int tmin = 0;
    { float q2 = 0.f;
#pragma unroll
      for (int s = 0; s < 4; ++s) { const u32x4 qw = __builtin_bit_cast(u32x4, qf[s]);
#pragma unroll
          for (int i = 0; i < 4; ++i) { const float a = bflo(qw[i]), c2 = bfhi(qw[i]); q2 += a * a + c2 * c2; } }
      q2 = sw32_sum(q2);
      q2 = row16_max(sw16_max(q2));
      const float k2 = __builtin_bit_cast(float, A.kn2[(b * 16 + h * 2 + comp) * 2]) + __builtin_bit_cast(float, A.kn2[(b * 16 + h * 2 + comp) * 2 + 1]);
      float sb = sqrtf(q2 * k2) * 1.02f;
      LAS float* sbx = (LAS float*)(lds + 3 * DIFF_STG);
      if (lane == 0) sbx[w] = sb;
      __syncthreads();
#pragma unroll
      for (int i = 0; i < 8; ++i) sb = fmaxf(sb, sbx[i]);
      const float x = (float)(qb * 128) - (161.0f + 2.0f * sb) / slope2 - 63.0f;
      tmin = x > 0.f ? ((int)x) >> 6 : 0; if (tmin > NT - 1) tmin = NT - 1; }
    const char* kgb = (const char*)(A.proj + rowbase * PN + DK_OFF + h * 128); const char* vgb = (const char*)(A.proj + rowbase * PN + DV_OFF + h * 128);
    const unsigned kgo = (unsigned)(((tid >> 3) * PN + (tid & 7) * 8) * 2), vgo = (unsigned)(((tid >> 4) * PN + (tid & 15) * 8) * 2);
    const int kdst = (tid >> 3) * KSTR + (tid & 7) * 16, vdst = 2 * 64 * KSTR + (tid >> 4) * VSTR128 + (tid & 15) * 16;
    u32x4 ak0, ak1, av0, av1, bk0, bk1, bv0, bv1;
#define D_LOADX(t, K0, K1, V0, V1) do { const char* kt_ = kgb + (size_t)(t) * 64 * PN * 2; const char* vt_ = vgb + (size_t)(t) * 64 * PN * 2; K0 = *(const u32x4*)(kt_ + kgo); K1 = *(const u32x4*)(kt_ + 128 + kgo); V0 = *(const u32x4*)(vt_ + vgo); V1 = *(const u32x4*)(vt_ + (size_t)32 * PN * 2 + vgo); } while (0)
#define D_LOADA(t) D_LOADX(t, ak0, ak1, av0, av1)
#define D_LOADB(t) D_LOADX(t, bk0, bk1, bv0, bv1)
#define D_WRITEX(bf, K0, K1, V0, V1) do { LAS unsigned char* b_ = lds + (bf) * DIFF_STG; *(LAS u32x4*)(b_ + kdst) = K0; *(LAS u32x4*)(b_ + 64 * KSTR + kdst) = K1; *(LAS u32x4*)(b_ + vdst) = V0; *(LAS u32x4*)(b_ + vdst + 32 * VSTR128) = V1; } while (0)
#define D_WRITEA(bf) D_WRITEX(bf, ak0, ak1, av0, av1)
#define D_WRITEB(bf) D_WRITEX(bf, bk0, bk1, bv0, bv1)
#define D_NEXT(t) (((t) - 1 >= tmin) ? (t) - 1 : -1)
#define D_STEP(t, bc, bp) do { const int k0_ = (t) * 64; LAS const unsigned char* b_ = lds + (bc) * DIFF_STG; LAS const unsigned char* vp_ = lds + (bp) * DIFF_STG + 2 * 64 * KSTR; f32x16 p0, p1; \
        qk_tile(p0, p1, b_ + comp * 64 * KSTR, qf, r32, hi); const float dn0_ = (float)(k0_ - tq + 4 * hi); \
        if (k0_ + 63 > q0w) sm_pv_step<4, VSTR128, true>(p0, p1, slope2, dn0_, 1.0f, NEG_INF, 0.0f, slope2 * dn0_, slope2 * (dn0_ + 32.0f), m, l, o, pfo, vp_, lane); \
        else sm_pv_step<4, VSTR128, false>(p0, p1, slope2, dn0_, 1.0f, NEG_INF, 0.0f, slope2 * dn0_, slope2 * (dn0_ + 32.0f), m, l, o, pfo, vp_, lane); } while (0)
#define D_FINAL(bp) do { pv_tile<4, VSTR128>(o, lds + (bp) * DIFF_STG + 2 * 64 * KSTR, pfo, lane); } while (0)
    bf16x8 pfo[4];
#pragma unroll
    for (int i = 0; i < 4; ++i) pfo[i] = (bf16x8){0, 0, 0, 0, 0, 0, 0, 0};
    STREAM_LOOP3(NT - 1, D_NEXT, D_LOADA, D_LOADB, D_WRITEA, D_WRITEB, D_STEP, D_FINAL);
#undef D_LOADX
#undef D_LOADA
#undef D_LOADB
#undef D_WRITEX
#undef D_WRITEA
#undef D_WRITEB
#undef D_NEXT
#undef D_STEP
#undef D_FINAL
    const float inv_l = 1.0f / l;
    LAS float* xch = (LAS float*)lds;
    if (comp == 1) {
#pragma unroll
        for (int d = 0; d < 4; ++d)
#pragma unroll
            for (int r = 0; r < 16; ++r) xch[((qs * 4 + d) * 16 + r) * 64 + lane] = o[d][r] * inv_l;
    }
    __syncthreads();
    if (comp == 0) {
        const float lam = A.lam[0]; float ss = 0.f;
#pragma unroll
        for (int d = 0; d < 4; ++d)
#pragma unroll
            for (int r = 0; r < 16; ++r) { const float v = o[d][r] * inv_l - lam * xch[((qs * 4 + d) * 16 + r) * 64 + lane]; o[d][r] = v; ss += v * v; }
        ss = sw32_sum(ss);
        const float rs = __builtin_amdgcn_rsqf(ss * (1.0f / 128.0f) + LN_EPS) * ((1.0f - LAMBDA_INIT) * ODSCALE);
        unsigned char* op = (unsigned char*)A.odiff + (rowbase + tq) * (2 * DM) + h * 128 + 16 * hi;
#pragma unroll
        for (int d = 0; d < 4; ++d) { unsigned wq[4];
#pragma unroll
            for (int gr = 0; gr < 4; ++gr) { const int d0 = 32 * d + 8 * gr; const f32x4 g4 = *(const f32x4*)(A.subln + d0 + 4 * hi);
                wq[gr] = pack4_fp8(o[d][4 * gr] * rs * g4[0], o[d][4 * gr + 1] * rs * g4[1], o[d][4 * gr + 2] * rs * g4[2], o[d][4 * gr + 3] * rs * g4[3]); }
            *(u32x4*)(op + 32 * d) = widen16(wq); }
    }
    __syncthreads();
}

struct NsaArgs { const bf16* proj; const bf16* kcmp; bf16* onsa; };
constexpr int NSA_STG = 64 * KSTR + 64 * VSTR64;
constexpr int NSA_IMPA = 2 * NSA_STG, NSA_IMPB = NSA_IMPA + 8 * 8 * 64 * 4, NSA_SEL = NSA_IMPB + 8 * 8 * 64 * 4, NSA_WOR = NSA_SEL + 64 * 8, NSA_RES = NSA_WOR + 8 * 8, NSA_LDS = NSA_RES + 8 * 8192;
DI void nsa_unit(const NsaArgs& A, int b, int g, int qb, LAS unsigned char* lds, int tid) {
    asm volatile("" : "+v"(tid));
    const int lane = tid & 63, w = __builtin_amdgcn_readfirstlane(tid >> 6), c = lane & 31, hi = lane >> 5;
    const int ql = c >> 2, hd = c & 3, head = 4 * g + hd, tq = 64 * qb + 8 * w + ql;
    const size_t rowbase = (size_t)b * SEQ, row = rowbase + tq;
    const float slope2 = __builtin_amdgcn_exp2f(-0.5f * (float)(head + 1)) * LOG2E;
    bf16x8 qf[4];
    { const bf16* qp = A.proj + row * PN + NQ_OFF + head * 64 + hi * 8;
#pragma unroll
      for (int s = 0; s < 4; ++s) qf[s] = *(const bf16x8*)(qp + 16 * s); }
    float gt0, gt1, gt2;
    { const bf16* gp = A.proj + row * PN + NG_OFF + head * 3; gt0 = bf2f(gp[0]); gt1 = bf2f(gp[1]); gt2 = bf2f(gp[2]); }
    f32x16 o[2];
#pragma unroll
    for (int d = 0; d < 2; ++d)
#pragma unroll
        for (int r = 0; r < 16; ++r) o[d][r] = 0.f;
    LAS float* resl = (LAS float*)(lds + NSA_RES) + w * 2048 + lane;
    LAS float* impA = (LAS float*)(lds + NSA_IMPA) + w * 512;
    LAS float* impB = (LAS float*)(lds + NSA_IMPB) + w * 512;
    LAS unsigned long long* selm = (LAS unsigned long long*)(lds + NSA_SEL);
    LAS unsigned long long* worm = (LAS unsigned long long*)(lds + NSA_WOR);
#pragma unroll
    for (int i = 0; i < 8; ++i) { impA[i * 64 + lane] = 0.f; impB[i * 64 + lane] = 0.f; }
    const int krow = tid >> 3, kch = tid & 7, kdst = krow * KSTR + kch * 16, vdst = 64 * KSTR + krow * VSTR64 + kch * 16;
    u32x4 ska, sva, skb, svb;
#define N_WRITEA(bf) do { LAS unsigned char* b_ = lds + (bf) * NSA_STG; *(LAS u32x4*)(b_ + kdst) = ska; *(LAS u32x4*)(b_ + vdst) = sva; } while (0)
#define N_WRITEB(bf) do { LAS unsigned char* b_ = lds + (bf) * NSA_STG; *(LAS u32x4*)(b_ + kdst) = skb; *(LAS u32x4*)(b_ + vdst) = svb; } while (0)
    const int ntc = (4 * qb + 3 + 63) >> 6;
    const char* kcb = (const char*)(A.kcmp + (size_t)(b * 4 + g) * 256 * 256);
    const unsigned cgo = (unsigned)((krow * 256 + kch * 8) * 2), pgo = (unsigned)((krow * PN + kch * 8) * 2);
    f32x16 cK;
#pragma unroll
    for (int r = 0; r < 16; ++r) cK[r] = slope2 * 16.0f * (float)KR(r);
    float m1 = -1e30f, l1 = 0.f;
#define C_NEXT(t) ((t) - 1)
#define C_LOADX(t, SK, SV) do { SK = *(const u32x4*)(kcb + (size_t)(t) * 64 * 256 * 2 + cgo); SV = *(const u32x4*)(kcb + (size_t)8192 * 256 * 2 + (size_t)(t) * 64 * 256 * 2 + cgo); } while (0)
#define C_LOADA(t) C_LOADX(t, ska, sva)
#define C_LOADB(t) C_LOADX(t, skb, svb)
#define C_DN0(t) ((float)(1024 * (t) + 31 - tq + 64 * hi))
#define C_COMP1(t, bf) do { f32x16 p0, p1; qk_tile_c(p0, p1, lds + (bf) * NSA_STG, qf, c, hi, cK); const float dn0_ = C_DN0(t); \
        if (1024 * (t) + 1039 > 64 * qb + 8 * w) mask_only(p0, p1, dn0_, 16.0f, NEG_INF, 0.0f);        \
        softmax_stats(p0, p1, slope2 * dn0_, slope2 * (dn0_ + 512.0f), m1, l1); } while (0)
    STREAM_LOOP2(ntc - 1, C_NEXT, C_LOADA, C_LOADB, N_WRITEA, N_WRITEB, C_COMP1);
    const float il1 = l1 > 0.f ? 1.0f / l1 : 0.f;
#define C_COMP2(t, bf) do { f32x16 p0, p1; bf16x8 pf[4]; LAS const unsigned char* b_ = lds + (bf) * NSA_STG; qk_tile_c(p0, p1, b_, qf, c, hi, cK); const float dn0_ = C_DN0(t); \
        if (1024 * (t) + 1039 > 64 * qb + 8 * w) mask_only(p0, p1, dn0_, 16.0f, NEG_INF, 0.0f); \
        softmax_fixed(p0, p1, slope2 * dn0_, slope2 * (dn0_ + 512.0f), m1, pf); \
        pv_tile<2, VSTR64>(o, b_ + 64 * KSTR, pf, lane); \
        _Pragma("unroll") for (int bb = 0; bb < 2; ++bb) _Pragma("unroll") for (int gr = 0; gr < 4; ++gr) { \
            const float x0 = (bb ? p1[4 * gr] : p0[4 * gr]) * il1, x1 = (bb ? p1[4 * gr + 1] : p0[4 * gr + 1]) * il1, x2 = (bb ? p1[4 * gr + 2] : p0[4 * gr + 2]) * il1, x3 = (bb ? p1[4 * gr + 3] : p0[4 * gr + 3]) * il1; \
            float av = ((x0 + x1) + x2) + 0.5f * x3, bv = 0.5f * x3; av += dpp_get<0xB1>(av); bv += dpp_get<0xB1>(bv); av += dpp_get<0x4E>(av); bv += dpp_get<0x4E>(bv); \
            const int j2_ = 16 * (t) + 8 * bb + 2 * gr + hi; if (hd == 0) { impA[ql * 64 + j2_] = av; if (j2_ + 1 < 64) impB[ql * 64 + j2_ + 1] = bv; } } } while (0)
    STREAM_LOOP2(ntc - 1, C_NEXT, C_LOADA, C_LOADB, N_WRITEA, N_WRITEB, C_COMP2);
#pragma unroll
    for (int d = 0; d < 2; ++d)
#pragma unroll
        for (int r = 0; r < 16; ++r) { resl[(d * 16 + r) * 64] = o[d][r] * (gt0 * il1); o[d][r] = 0.f; }
    const int cur = qb;
    unsigned long long wor = 0ull, wand = ~0ull;
    if (cur < 16) {
        const unsigned long long mk = __ballot(lane <= cur);
        if (lane < 8) selm[w * 8 + lane] = mk;
        wor = mk; wand = mk;
    } else {
        unsigned key[8], thr[8];
#pragma unroll
        for (int qi = 0; qi < 8; ++qi) { float v = impA[qi * 64 + lane] + impB[qi * 64 + lane];
            if (lane == 0 || lane == cur || lane == cur - 1) v = 1e30f;
            key[qi] = lane <= cur ? __builtin_bit_cast(unsigned, v) + 1u : 0u; thr[qi] = 0u; }
        for (int bit = 31; bit >= 0; --bit) {
#pragma unroll
            for (int qi = 0; qi < 8; ++qi) { const unsigned cand = thr[qi] | (1u << bit); if (__popcll(__ballot(key[qi] >= cand)) >= 16) thr[qi] = cand; }
        }
#pragma unroll
        for (int qi = 0; qi < 8; ++qi) {
            const unsigned long long gt = __ballot(key[qi] > thr[qi]), eq = __ballot(key[qi] == thr[qi]);
            const int need = 16 - __popcll(gt);
            const int below = (int)__builtin_amdgcn_mbcnt_hi((unsigned)(eq >> 32), __builtin_amdgcn_mbcnt_lo((unsigned)eq, 0u));
            const unsigned long long mk = gt | __ballot(key[qi] == thr[qi] && below < need);
            if (lane == 0) selm[w * 8 + qi] = mk;
            wor |= mk; wand &= mk;
        }
    }
    if (lane == 0) worm[w] = wor;
    __syncthreads();
    unsigned long long bmask = 0ull;
#pragma unroll
    for (int i = 0; i < 8; ++i) bmask |= worm[i];
    const unsigned long long mym = selm[w * 8 + ql];
    const char* pgb = (const char*)(A.proj + rowbase * PN + g * 64);
#pragma unroll
    for (int r = 0; r < 16; ++r) cK[r] = slope2 * (float)KR(r);
    float m = -1e30f, l = 0.f;
#define S_FIRST (63 - (int)__builtin_clzll(bmask))
#define S_NEXT(j) (((bmask & ((1ull << (j)) - 1ull)) == 0ull) ? -1 : 63 - (int)__builtin_clzll(bmask & ((1ull << (j)) - 1ull)))
#define S_LOADX(j, SK, SV) do { const char* t_ = pgb + (size_t)(j) * 64 * PN * 2; SK = *(const u32x4*)(t_ + KS_OFF * 2 + pgo); SV = *(const u32x4*)(t_ + VS_OFF * 2 + pgo); } while (0)
#define S_LOADA(j) S_LOADX(j, ska, sva)
#define S_LOADB(j) S_LOADX(j, skb, svb)
#define S_COMP(j, bf) do { if ((wor >> (j)) & 1ull) { f32x16 p0, p1; bf16x8 pf[4]; LAS const unsigned char* b_ = lds + (bf) * NSA_STG; qk_tile_c(p0, p1, b_, qf, c, hi, cK); \
        const float dn0_ = (float)(64 * (j) - tq + 4 * hi); const float hi_ = ((mym >> (j)) & 1ull) ? 0.0f : NEG_INF; \
        if ((j) == cur || !((wand >> (j)) & 1ull)) mask_only(p0, p1, dn0_, 1.0f, NEG_INF, hi_); \
        bf16x8 vf_[2][4]; pv_load<2, VSTR64>(vf_, b_ + 64 * KSTR, lane); \
        softmax_pv<2>(p0, p1, slope2 * dn0_, slope2 * (dn0_ + 32.0f), m, l, o, vf_); } } while (0)
    STREAM_LOOP2(S_FIRST, S_NEXT, S_LOADA, S_LOADB, N_WRITEA, N_WRITEB, S_COMP);
    { const float sc = gt1 / l;
#pragma unroll
      for (int d = 0; d < 2; ++d)
#pragma unroll
          for (int r = 0; r < 16; ++r) { resl[(d * 16 + r) * 64] += o[d][r] * sc; o[d][r] = 0.f; } }
    m = -1e30f; l = 0.f;
    const int wfirst = qb >= 8 ? qb - 8 : 0;
#define W_NEXT(j) (((j) - 1 >= wfirst) ? (j) - 1 : -1)
#define W_LOADX(j, SK, SV) do { const char* t_ = pgb + (size_t)(j) * 64 * PN * 2; SK = *(const u32x4*)(t_ + KW_OFF * 2 + pgo); SV = *(const u32x4*)(t_ + VW_OFF * 2 + pgo); } while (0)
#define W_LOADA(j) W_LOADX(j, ska, sva)
#define W_LOADB(j) W_LOADX(j, skb, svb)
#define W_COMP(j, bf) do { f32x16 p0, p1; bf16x8 pf[4]; LAS const unsigned char* b_ = lds + (bf) * NSA_STG; qk_tile_c(p0, p1, b_, qf, c, hi, cK); \
        const float dn0_ = (float)(64 * (j) - tq + 4 * hi); \
        if ((j) == qb || (j) == qb - 8) mask_only(p0, p1, dn0_, 1.0f, -511.0f, 0.0f); \
        bf16x8 vf_[2][4]; pv_load<2, VSTR64>(vf_, b_ + 64 * KSTR, lane); \
        softmax_pv<2>(p0, p1, slope2 * dn0_, slope2 * (dn0_ + 32.0f), m, l, o, vf_); } while (0)
    STREAM_LOOP2(qb, W_NEXT, W_LOADA, W_LOADB, N_WRITEA, N_WRITEB, W_COMP);
    { const float sc = gt2 / l;
      unsigned char* op = (unsigned char*)A.onsa + row * (2 * DM) + DM + head * 64 + 16 * hi;
#pragma unroll
      for (int d = 0; d < 2; ++d) { unsigned wq[4];
#pragma unroll
          for (int gr = 0; gr < 4; ++gr)
              wq[gr] = pack4_fp8((resl[(d * 16 + 4 * gr) * 64] + o[d][4 * gr] * sc) * ONSCALE, (resl[(d * 16 + 4 * gr + 1) * 64] + o[d][4 * gr + 1] * sc) * ONSCALE,
                                 (resl[(d * 16 + 4 * gr + 2) * 64] + o[d][4 * gr + 2] * sc) * ONSCALE, (resl[(d * 16 + 4 * gr + 3) * 64] + o[d][4 * gr + 3] * sc) * ONSCALE);
          *(u32x4*)(op + 32 * d) = widen16(wq); } }
#undef N_WRITEA
#undef N_WRITEB
#undef C_NEXT
#undef C_LOADX
#undef C_LOADA
#undef C_LOADB
#undef C_DN0
#undef C_COMP1
#undef C_COMP2
#undef S_FIRST
#undef S_NEXT
#undef S_LOADX
#undef S_LOADA
#undef S_LOADB
#undef S_COMP
#undef W_NEXT
#undef W_LOADX
#undef W_LOADA
#undef W_LOADB
#undef W_COMP
}

constexpr size_t MiB = 1u << 20;
constexpr size_t WS_PROJ = 0;
constexpr size_t WS_XB = 496 * MiB;
constexpr size_t WS_ODIFF = 496 * MiB;
constexpr size_t WS_ONSA = 560 * MiB;
constexpr size_t WS_XQ = 560 * MiB;
constexpr size_t WS_WIN = 624 * MiB;
constexpr size_t WS_BLK = 640 * MiB;
constexpr size_t WS_HID = 704 * MiB;
constexpr size_t WS_CMP = 712 * MiB;
constexpr size_t WS_MIXED = 720 * MiB;
constexpr size_t WS_T1 = 784 * MiB;
constexpr size_t WS_HPRE = 0;
constexpr size_t WS_WE2A = 848 * MiB;
constexpr size_t WS_WE2B = 912 * MiB;
constexpr int WE2_SPLIT = 24, WE2_GAP_PN = (int)((WS_WE2B - (WS_WE2A + (size_t)WE2_SPLIT * 2 * MiB)) / (512 * 1024));
constexpr size_t WS_B1H = 784 * MiB;
constexpr size_t WS_B2H = 785 * MiB;
constexpr size_t WS_HB = 192 * MiB;
constexpr size_t WS_HQ = 128 * MiB;
constexpr size_t WS_XG = 256 * MiB;
constexpr size_t WS_ACT = 528 * MiB;
constexpr size_t WS_SMALLW = 896 * MiB;
constexpr size_t WS_PHI1 = WS_SMALLW;
constexpr size_t WS_PHI2 = WS_SMALLW + 2 * MiB;
constexpr size_t WS_WBRD = WS_SMALLW + 3 * MiB;
constexpr size_t WS_WBRN = WS_SMALLW + 5 * MiB;
constexpr size_t WS_WO = WS_SMALLW + 7 * MiB;
constexpr size_t WS_WPG = WS_SMALLW + 9 * MiB;
constexpr size_t WS_WPP = WS_SMALLW + 11 * MiB;
constexpr size_t WS_BIASIN = WS_SMALLW + 12 * MiB;
constexpr size_t WS_LAM = WS_SMALLW + 13 * MiB;
constexpr size_t WS_WMGQ = WS_SMALLW + 14 * MiB;
constexpr size_t WS_PB = 912 * MiB;
constexpr size_t WS_PLE = 928 * MiB;
constexpr size_t WS_ROUTE = 992 * MiB;
constexpr size_t WS_TOPE = WS_ROUTE;
constexpr size_t WS_GATE = WS_ROUTE + 1 * MiB;
constexpr size_t WS_POS = WS_ROUTE + 2 * MiB;
constexpr size_t WS_SLOTOF = WS_ROUTE + 3 * MiB;
constexpr size_t WS_SLOTGATE = WS_ROUTE + 4 * MiB;
constexpr size_t WS_BLKE = WS_ROUTE + 5 * MiB;
constexpr size_t WS_SLOTTOK = WS_ROUTE + 6 * MiB;
constexpr size_t WS_CTL = 1000 * MiB;
constexpr size_t CTL_BYTES = 65536;
constexpr size_t WS_NEED = 1001 * MiB;

constexpr int LDS_BYTES = 147456;
constexpr int LDS_ITEM = LDS_BYTES - 64;

struct Args {
    const float* in[32]; float* out; unsigned char* ws; int ph_lo, ph_hi;
};

DI int lane_id() { int l; asm volatile("v_mbcnt_lo_u32_b32 %0, -1, 0\n\tv_mbcnt_hi_u32_b32 %0, -1, %0" : "=v"(l)); return l; }
DI float wave_sum(float v) { return sw32_sum(sw16_sum(row16_sum(v))); }
DI void convert_rows(const float* src, bf16* dst, size_t n8, size_t gtid, size_t nthr) {
    size_t i = gtid;
    for (; i + 3 * nthr < n8; i += 4 * nthr) {
        f32x4 a[4], b[4];
#pragma unroll
        for (int u = 0; u < 4; ++u) { a[u] = __builtin_nontemporal_load((const f32x4*)(src + 8 * (i + u * nthr))); b[u] = __builtin_nontemporal_load((const f32x4*)(src + 8 * (i + u * nthr) + 4)); }
#pragma unroll
        for (int u = 0; u < 4; ++u) *(u32x4*)(dst + 8 * (i + u * nthr)) = pack8(a[u], b[u]);
    }
    for (; i < n8; i += nthr) { const f32x4 a = *(const f32x4*)(src + 8 * i), b = *(const f32x4*)(src + 8 * i + 4); *(u32x4*)(dst + 8 * i) = pack8(a, b); }
}
DI void convert_rows_2(const float* src, bf16* dst, unsigned char* dst8, size_t n8, size_t gtid, size_t nthr) {
    size_t i = gtid;
    for (; i + 3 * nthr < n8; i += 4 * nthr) {
        f32x4 a[4], b[4];
#pragma unroll
        for (int u = 0; u < 4; ++u) { a[u] = __builtin_nontemporal_load((const f32x4*)(src + 8 * (i + u * nthr))); b[u] = __builtin_nontemporal_load((const f32x4*)(src + 8 * (i + u * nthr) + 4)); }
#pragma unroll
        for (int u = 0; u < 4; ++u) { *(u32x4*)(dst + 8 * (i + u * nthr)) = pack8(a[u], b[u]);
            u32x2 o8; o8.x = pack4_fp8(a[u][0], a[u][1], a[u][2], a[u][3]); o8.y = pack4_fp8(b[u][0], b[u][1], b[u][2], b[u][3]); *(u32x2*)(dst8 + 8 * (i + u * nthr)) = o8; }
    }
    for (; i < n8; i += nthr) { const f32x4 a = *(const f32x4*)(src + 8 * i), b = *(const f32x4*)(src + 8 * i + 4); *(u32x4*)(dst + 8 * i) = pack8(a, b);
        u32x2 o8; o8.x = pack4_fp8(a[0], a[1], a[2], a[3]); o8.y = pack4_fp8(b[0], b[1], b[2], b[3]); *(u32x2*)(dst8 + 8 * i) = o8; }
}
template <int MODE> DI void transpose_item(const float* W, int K, int N, bf16* WT, int row_off, LAS float* scr, int item, int lane, bool f8 = false, int ldk8 = 0) {
    const int nblk = (N + 31) >> 5, kb = item / nblk, nb = item - kb * nblk, k0 = 64 * kb, n0 = 32 * nb;
    const int nn = n0 + (lane & 31);
#pragma unroll 8
    for (int i = 0; i < 32; ++i) { const int kk = 2 * i + (lane >> 5); scr[kk * 33 + (lane & 31)] = nn < N ? __builtin_nontemporal_load(W + (size_t)(k0 + kk) * N + nn) : 0.f; }
    asm volatile("s_waitcnt lgkmcnt(0)" ::: "memory");
    const int cc = lane & 7;
#pragma unroll
    for (int j = 0; j < 4; ++j) { const int nl = (lane >> 3) + 8 * j, n = n0 + nl; const LAS float* s = scr + (8 * cc) * 33 + nl;
        u32x4 ov; ov.x = pk2(s[0], s[33]); ov.y = pk2(s[2 * 33], s[3 * 33]); ov.z = pk2(s[4 * 33], s[5 * 33]); ov.w = pk2(s[6 * 33], s[7 * 33]);
        int dr; if (MODE == 1) { const int bj = n >> 10, c2 = n & 1023; dr = (c2 >> 7) * 256 + bj * 128 + (c2 & 127); } else dr = row_off + n;
        if (f8) { u32x2 o8; o8.x = pack4_fp8(s[0] * W1SCALE, s[33] * W1SCALE, s[2 * 33] * W1SCALE, s[3 * 33] * W1SCALE); o8.y = pack4_fp8(s[4 * 33] * W1SCALE, s[5 * 33] * W1SCALE, s[6 * 33] * W1SCALE, s[7 * 33] * W1SCALE);
            if (n < N) *(u32x2*)((unsigned char*)WT + (size_t)dr * (ldk8 ? ldk8 : K) + k0 + 8 * cc) = o8; }
        else if (n < N) *(u32x4*)(WT + (size_t)dr * K + k0 + 8 * cc) = ov; }
    asm volatile("s_waitcnt lgkmcnt(0)" ::: "memory");
}
template <int MODE, bool F8 = false> DI void transpose_big64(const float* W, int K, int N, bf16* WT, LAS float* scr, int item, int lane, float sc = 1.0f) {
    const int nblk = N >> 6, kb = item / nblk, nb = item - kb * nblk, k0 = 64 * kb, n0 = 64 * nb;
    { const int c4 = (lane & 15) * 4, r0 = lane >> 4;
#pragma unroll 4
      for (int i = 0; i < 16; ++i) { const int kk = 4 * i + r0; const f32x4 v = __builtin_nontemporal_load((const f32x4*)(W + (size_t)(k0 + kk) * N + n0 + c4));
          *(LAS f32x4*)(scr + kk * 68 + ((c4 + 4 * (kk >> 3)) & 63)) = v; } }
    asm volatile("s_waitcnt lgkmcnt(0)" ::: "memory");
    const int kc = lane & 7;
#pragma unroll
    for (int j = 0; j < 8; ++j) { const int nl = (lane >> 3) + 8 * j, n = n0 + nl; const LAS float* s = scr + (8 * kc) * 68 + ((nl + 4 * kc) & 63);
        u32x4 ov; ov.x = pk2(s[0], s[68]); ov.y = pk2(s[2 * 68], s[3 * 68]); ov.z = pk2(s[4 * 68], s[5 * 68]); ov.w = pk2(s[6 * 68], s[7 * 68]);
        int dr; if (MODE == 1) { const int bj = n >> 10, c2 = n & 1023; dr = (c2 >> 7) * 256 + bj * 128 + (c2 & 127); } else dr = n;
        if constexpr (F8) { u32x2 o8; o8.x = pack4_fp8(s[0] * sc, s[68] * sc, s[2 * 68] * sc, s[3 * 68] * sc); o8.y = pack4_fp8(s[4 * 68] * sc, s[5 * 68] * sc, s[6 * 68] * sc, s[7 * 68] * sc);
            *(u32x2*)((unsigned char*)WT + (size_t)dr * K + k0 + 8 * kc) = o8; }
        else *(u32x4*)(WT + (size_t)dr * K + k0 + 8 * kc) = ov; }
    asm volatile("s_waitcnt lgkmcnt(0)" ::: "memory");
}
struct TrJob { const float* W; int K, N; bf16* WT; int row_off; };

#define RLX_AGENT __ATOMIC_RELAXED, __HIP_MEMORY_SCOPE_AGENT
#define XB_TMO      128
#define XB_XCNT(j)  (256  + 64 * (j))
#define XB_XSUB(j)  (1280 + 64 * (j))
#define XB_XGEN(j)  (2304 + 64 * (j))
#define XB_TOP      3328
#define XB_TOPGEN   3392
#define XCD_BAR_WORDS 3456
#define XB_SPIN_CAP (1u << 18)

__device__ __forceinline__ unsigned xb_ld(unsigned* p)              { return __hip_atomic_load(p, __ATOMIC_RELAXED, __HIP_MEMORY_SCOPE_AGENT); }
__device__ __forceinline__ unsigned xb_add(unsigned* p, unsigned v) { return __hip_atomic_fetch_add(p, v, __ATOMIC_RELAXED, __HIP_MEMORY_SCOPE_AGENT); }
__device__ __forceinline__ unsigned xb_xcc_id() { return (unsigned)__builtin_amdgcn_s_getreg((3 << 11) | 20) & 0xFu; }
#define XB_SPIN(cond, bar) do { unsigned _sp = 0; while (cond) { __builtin_amdgcn_s_sleep(1); \
    if ((++_sp & 255u) == 0u) { if (xb_ld(&(bar)[XB_TMO])) break; if (_sp > XB_SPIN_CAP) { atomicAdd(&(bar)[XB_TMO], 1u); break; } } } } while (0)

struct XcdBarrier {
    unsigned* bar; unsigned x;
    volatile LAS unsigned* st;
};

__device__ __forceinline__ XcdBarrier xcd_barrier_post(unsigned* bar, volatile LAS unsigned* st, const int tid) {
    XcdBarrier b; b.bar = bar; b.x = xb_xcc_id(); b.st = st;
    if (tid == 0) (void)xb_add(&bar[XB_XCNT(b.x)], 1u);
    return b;
}
__device__ __forceinline__ void xcd_barrier_complete(unsigned* bar, unsigned x, unsigned& nloc, unsigned& nx) {
    const unsigned G = gridDim.x * gridDim.y * gridDim.z;
    unsigned sum, cnt, mine, sp = 0u;
    for (;;) {
        sum = 0u; cnt = 0u; mine = 0u;
#pragma unroll
        for (unsigned j = 0; j < 16; ++j) { const unsigned c = xb_ld(&bar[XB_XCNT(j)]); sum += c; cnt += (c > 0u) ? 1u : 0u; mine = (j == x) ? c : mine; }
        if (sum == G) break;
        __builtin_amdgcn_s_sleep(1);
        if ((++sp & 255u) == 0u) { if (xb_ld(&bar[XB_TMO])) break; if (sp > XB_SPIN_CAP) { atomicAdd(&bar[XB_TMO], 1u); break; } }
    }
    nloc = mine > 0u ? mine : 1u; nx = cnt > 0u ? cnt : 1u;
}

__device__ __forceinline__ void xcd_barrier(const XcdBarrier& b, const int tid) {
    asm volatile("s_waitcnt vmcnt(0)" ::: "memory");
    __syncthreads();
    if (tid == 0) {
        unsigned* bar = b.bar;
        __builtin_amdgcn_s_waitcnt(0);
        unsigned nloc = b.st[0], nx = b.st[1];
        if (nloc == 0u) { xcd_barrier_complete(bar, b.x, nloc, nx); b.st[0] = nloc; b.st[1] = nx; }
        const unsigned old = xb_add(&bar[XB_XSUB(b.x)], 1u);
        const unsigned gen = old / nloc;
        if (old + 1u == (gen + 1u) * nloc) {
            __builtin_amdgcn_fence(__ATOMIC_RELEASE, "agent");
            asm volatile("s_waitcnt vmcnt(0)" ::: "memory");
            const unsigned og = xb_add(&bar[XB_TOP], 1u);
            const unsigned tg = og / nx;
            if (og + 1u == (tg + 1u) * nx) xb_add(&bar[XB_TOPGEN], 1u);
            else XB_SPIN(xb_ld(&bar[XB_TOPGEN]) == tg, bar);
            __builtin_amdgcn_fence(__ATOMIC_ACQUIRE, "agent");
            xb_add(&bar[XB_XGEN(b.x)], 1u);
            asm volatile("s_waitcnt vmcnt(0)" ::: "memory");
        } else {
            XB_SPIN(xb_ld(&bar[XB_XGEN(b.x)]) == gen, bar);
            __builtin_amdgcn_fence(__ATOMIC_ACQUIRE, "agent");
            asm volatile("s_waitcnt vmcnt(0)" ::: "memory");
        }
    }
    __syncthreads();
}


constexpr int NPHASE = 13;
__global__ void __launch_bounds__(512, 2) mk_fwd(Args a) {
    extern __shared__ __attribute__((aligned(16))) unsigned char lds_raw[];
    LAS unsigned char* lds = (LAS unsigned char*)lds_raw;
    const int wave = __builtin_amdgcn_readfirstlane((int)threadIdx.x >> 6);
    const int G = gridDim.x, bx = blockIdx.x;
    const int vcu = (G % 8 == 0) ? (bx % 8) * (G / 8) + bx / 8 : bx;
    const int gw = bx * 8 + wave, NGW = G * 8;
    const size_t nthr = (size_t)G * 512;
    typedef __attribute__((address_space(4))) const Args* kargp_t;
    const kargp_t kap = (kargp_t)__builtin_amdgcn_kernarg_segment_ptr();
#define PHASE_VARS const int lane = lane_id(); const int tid = wave * 64 + lane; const size_t gtid = (size_t)bx * 512 + tid; (void)gtid; kargp_t ap = kap; asm volatile("" : "+s"(ap)); unsigned char* const ws = ap->ws; float* const out = ap->out; (void)out; (void)ws;
#define WSP(T, OFF) ((T*)(ws + (OFF)))
    if (kap->ph_lo < 0) { cg::grid_group grid = cg::this_grid(); grid.sync(); }
    const int lo = kap->ph_lo, hi = kap->ph_hi;
#ifndef PHMASK
#define PHMASK 0x1fff
#endif
#define IN(k) (((PHMASK >> (k)) & 1) && lo <= (k) && (k) < hi)
    volatile LAS unsigned* bar_st = (volatile LAS unsigned*)(lds + LDS_BYTES - 32);
    const bool multi_phase = (hi - lo) > 1;
    XcdBarrier bar; bar.bar = nullptr; bar.x = 0; bar.st = bar_st;
    { const int lane0 = lane_id(); const int tid0 = wave * 64 + lane0;
      if (tid0 < 2) bar_st[tid0] = 0u;
      __syncthreads();
      if (multi_phase) bar = xcd_barrier_post((unsigned*)(kap->ws + WS_CTL) + 1024, bar_st, tid0); }
#define SEAM(k) do { if (IN(k) && IN((k) + 1)) { { const int l_ = lane_id(); xcd_barrier(bar, wave * 64 + l_); } } } while (0)

    if (IN(0)) { PHASE_VARS
        const float* x = ap->in[0]; bf16* xb = WSP(bf16, WS_XB); bf16* pb = WSP(bf16, WS_PB); bf16* win_t = WSP(bf16, WS_WIN); bf16* wbrd_t = WSP(bf16, WS_WBRD); bf16* wbrn_t = WSP(bf16, WS_WBRN); bf16* wo_t = WSP(bf16, WS_WO);
        bf16* wpg_t = WSP(bf16, WS_WPG); bf16* wpp_t = WSP(bf16, WS_WPP); bf16* phi1_t = WSP(bf16, WS_PHI1); bf16* phi2_t = WSP(bf16, WS_PHI2); float* bias_in = WSP(float, WS_BIASIN); float* lamp = WSP(float, WS_LAM);
        convert_rows_2(x, xb, WSP(unsigned char, WS_XQ), (size_t)NTOK * DM / 8, gtid, nthr);
        bf16* wmg_q = WSP(bf16, WS_WMGQ);
        convert_rows(ap->in[1], pb, (size_t)NTOK * 256 / 8, gtid, nthr);
        LAS float* scr = (LAS float*)(lds + wave * 16384);
        { constexpr int I0 = 16 * 178, I1 = 16 * 64, I2 = 16 * 32, I6 = 4 * 32, I7 = 32 * 8, I9 = 4 * 2;
          constexpr int NIT = I0 + I1 + 4 * I2 + I6 + 2 * I7 + 2 * I9;
          for (int it = gw; it < NIT; it += NGW) { int r = it; const float* W; int K, N, off; bf16* WT;
              if (r < I0) { W = ap->in[2]; K = DM; N = CIN; WT = win_t; off = 0; }
              else if ((r -= I0) < I1) { W = ap->in[16]; K = DM; N = 2 * DM; WT = wmg_q; off = 0; }
              else if ((r -= I1) < I2) { W = ap->in[14]; K = DM; N = DM; WT = wbrd_t; off = 0; }
              else if ((r -= I2) < I2) { W = ap->in[15]; K = DM; N = DM; WT = (bf16*)((unsigned char*)wbrd_t + DM); off = 0; }
              else if ((r -= I2) < I2) { W = ap->in[18]; K = DM; N = DM; WT = wo_t; off = 0; }
              else if ((r -= I2) < I2) { W = ap->in[27]; K = DM; N = DM; WT = wpg_t; off = 0; }
              else if ((r -= I2) < I6) { W = ap->in[29]; K = 256; N = DM; WT = wpp_t; off = 0; }
              else if ((r -= I6) < I7) { W = ap->in[10]; K = 2048; N = 256; WT = phi1_t; off = 0; }
              else if ((r -= I7) < I7) { W = ap->in[12]; K = 2048; N = 256; WT = phi1_t; off = 256; }
              else if ((r -= I7) < I9) { W = ap->in[11]; K = 256; N = 64; WT = phi2_t; off = 0; }
              else { r -= I9; W = ap->in[13]; K = 256; N = 64; WT = phi2_t; off = 256; }
              { const bool br_ = (W == ap->in[14] || W == ap->in[15]); transpose_item<0>(W, K, N, WT, off, scr, r, lane, WT == wpg_t || WT == wmg_q || br_, br_ ? 2 * DM : 0); } } }
        for (size_t i = gtid; i < (size_t)PN; i += nthr) bias_in[i] = i >= (size_t)MG_OFF ? ap->in[17][i - MG_OFF] : 0.f;
        { bf16* b1h = WSP(bf16, WS_B1H); bf16* b2h = WSP(bf16, WS_B2H);
          for (size_t i = gtid; i < (size_t)NEXP * 2 * DFF / 2; i += nthr) *(unsigned*)(b1h + 2 * i) = pk2(ap->in[24][2 * i], ap->in[24][2 * i + 1]);
          for (size_t i = gtid; i < (size_t)NEXP * DM / 2; i += nthr) *(unsigned*)(b2h + 2 * i) = pk2(ap->in[26][2 * i], ap->in[26][2 * i + 1]); }
        if (gtid == 0) { float s1 = 0.f, s2 = 0.f; for (int i = 0; i < 64; ++i) { s1 += ap->in[3][i] * ap->in[4][i]; s2 += ap->in[5][i] * ap->in[6][i]; } lamp[0] = expf(s1) - expf(s2) + LAMBDA_INIT; }
    }
    SEAM(0);
    if (IN(1)) { PHASE_VARS
        bf16* xb = WSP(bf16, WS_XB); bf16* win_t = WSP(bf16, WS_WIN); bf16* proj = WSP(bf16, WS_PROJ); float* bias_in = WSP(float, WS_BIASIN); bf16* pb = WSP(bf16, WS_PB); bf16* wpp_t = WSP(bf16, WS_WPP); bf16* ple = WSP(bf16, WS_PLE);
        { pg8::Gemm g{WSP(bf16, WS_XQ), WSP(bf16, WS_WMGQ), NTOK, 2 * DM, DM / 2}; pg8::StaticOrder S; S.init(NTOK, 2 * DM, G, bx); EpiProjT<true> E{proj, bias_in, MG_OFF / 256, nullptr};
          pg8::gemm_phase<EpiProjT<true>, pg8::StaticOrder, true, true, false, true>(lds, g, S, E, tid); }
        { pg8::Gemm g{xb, win_t, NTOK, MG_OFF, DM}; pg8::StaticOrder S; S.init(NTOK, MG_OFF, G, bx); EpiProjT<false> E{proj, bias_in, 0, WSP(int, WS_CTL) + 256};
          pg8::gemm_phase<EpiProjT<false>, pg8::StaticOrder, true, true>(lds, g, S, E, tid); }
        { pg8::Gemm g{pb, wpp_t, NTOK, DM, 256}; const int c0 = ((NTOK / 256) * (MG_OFF / 256)) % G; TailOrder S{(NTOK / 256) * (DM / 256), DM / 256, c0 ? G - c0 : G, c0 ? bx - c0 : bx}; EpiBf16<0, true> E{ple, DM, 0};
          pg8::gemm_phase<EpiBf16<0, true>, TailOrder, true, true>(lds, g, S, E, tid); }
    }
    SEAM(1);
    constexpr int NCONV = (32 * 512 + 32 * 256) / 8;
#define CONV_UNIT(cu_) do { int lane_v = lane; asm volatile("" : "+v"(lane_v)); LAS float* scr_ = (LAS float*)(lds + wave * 17408); const int it_ = (cu_) * 8 + wave; \
            if (it_ < 32 * 512) { const int e_ = it_ >> 9; transpose_big64<1, true>(ap->in[23] + (size_t)e_ * DM * 2 * DFF, DM, 2 * DFF, (bf16*)((unsigned char*)out + (size_t)e_ * 2 * DFF * DM), scr_, it_ & 511, lane_v, W1SCALE); } \
            else { const int i2_ = it_ - 32 * 512, e_ = i2_ >> 8; bf16* dst_ = (bf16*)(WSP(unsigned char, WS_WE2A) + (size_t)e_ * DM * DFF); \
                   transpose_big64<0, true>(ap->in[25] + (size_t)e_ * DFF * DM, DFF, DM, dst_, scr_, i2_ & 255, lane_v, W2SCALE); } \
            __syncthreads(); } while (0)
#define CONV_DRAIN() do { LAS int* cslot_ = (LAS int*)(lds + LDS_ITEM) + 1; int* cctl_ = WSP(int, WS_CTL); for (;;) { \
            if (tid == 0) *cslot_ = __hip_atomic_fetch_add(cctl_ + 210, 1, __ATOMIC_RELAXED, __HIP_MEMORY_SCOPE_AGENT); \
            __syncthreads(); const int cu_d = __builtin_amdgcn_readfirstlane(*cslot_); __syncthreads(); if (cu_d >= NCONV) break; CONV_UNIT(cu_d); } } while (0)
    if (IN(5)) { PHASE_VARS
        bf16* proj = WSP(bf16, WS_PROJ); bf16* odiff = WSP(bf16, WS_ODIFF); bf16* onsa = WSP(bf16, WS_ONSA); bf16* cmpb = WSP(bf16, WS_CMP); float* lamp = WSP(float, WS_LAM); int* ctl = WSP(int, WS_CTL);
        LAS int* item_slot = (LAS int*)(lds + LDS_ITEM);
        const DiffArgs DA{proj, odiff, ap->in[7], lamp, ctl + 256}; const NsaArgs NA{proj, cmpb, odiff};
        { bf16* blk = WSP(bf16, WS_BLK); bf16* hid = WSP(bf16, WS_HID);
          for (int pm = 0; pm < 64; ++pm) {
              { int owner = (pm >> 3) * 32 + (pm & 7); if (owner >= G) owner = pm % G; if (owner != bx) continue; }
              int lane_c = lane; asm volatile("" : "+v"(lane_c)); const int tid_c = wave * 64 + lane_c;
              for (int rr = pm * 256 + wave; rr < pm * 256 + 256; rr += 8) {
                  const int kv = rr >> 13, rem = rr & 8191, bg = rem >> 8, n = rem & 255, b = bg >> 2, g = bg & 3;
                  const int coff = (kv ? VC_OFF : KC_OFF) + g * 64; const float* pos = kv ? ap->in[9] : ap->in[8];
                  bf16* drow = blk + (size_t)rr * 2048;
#pragma unroll
                  for (int jj = 0; jj < 4; ++jj) { const int ch = lane_c + 64 * jj, l = ch >> 3, dd0 = (ch & 7) * 8; u32x4 ov = (u32x4){0u, 0u, 0u, 0u};
                      if (n < 255) { const u32x4 u = *(const u32x4*)(proj + ((size_t)b * SEQ + 16 * n + l) * PN + coff + dd0); f32x4 v0, v1; unpack8(u, v0, v1);
                          const f32x4 p0 = *(const f32x4*)(pos + l * 64 + dd0), p1 = *(const f32x4*)(pos + l * 64 + dd0 + 4); ov = pack8(v0 + p0, v1 + p1); }
                      *(u32x4*)(drow + ch * 8) = ov; } }
              asm volatile("s_waitcnt vmcnt(0)" ::: "memory"); __syncthreads(); __builtin_amdgcn_fence(__ATOMIC_ACQUIRE, "agent"); asm volatile("s_waitcnt vmcnt(0)" ::: "memory");
              { pg8::Gemm g{blk, WSP(bf16, WS_PHI1), 16384, 512, 2048}; OneUnit S{pm, pm >> 5}; EpiBf16<1> E{hid, 256, 1};
                pg8::gemm_phase<EpiBf16<1>, OneUnit, true, true>(lds, g, S, E, tid_c); }
              asm volatile("s_waitcnt vmcnt(0)" ::: "memory"); __syncthreads(); __builtin_amdgcn_fence(__ATOMIC_ACQUIRE, "agent"); asm volatile("s_waitcnt vmcnt(0)" ::: "memory");
              { pg8::Gemm g{hid, WSP(bf16, WS_PHI2), 16384, 512, 256}; OneUnit S{pm, pm >> 5}; EpiBf16<0> E{cmpb, 256, 1};
                pg8::gemm_phase<EpiBf16<0>, OneUnit, true, true>(lds, g, S, E, tid_c); }
              __builtin_amdgcn_fence(__ATOMIC_RELEASE, "agent"); asm volatile("s_waitcnt vmcnt(0)" ::: "memory"); __syncthreads();
              if (wave == 0) __hip_atomic_fetch_add(ctl + 201, 1, __ATOMIC_RELAXED, __HIP_MEMORY_SCOPE_AGENT);
          } }
        bool cmp_ok = false;
        const int xq = (int)(xb_xcc_id() & 7u);
        for (int qi = 0; qi < 8; ++qi) {
            const int q = (xq + qi) & 7;
            for (;;) {
                if (tid == 0) *item_slot = __hip_atomic_fetch_add(ctl + 64 + 16 * q, 1, __ATOMIC_RELAXED, __HIP_MEMORY_SCOPE_AGENT);
                __syncthreads();
                const int item = __builtin_amdgcn_readfirstlane(*item_slot);
                __syncthreads();
                if (item >= 512) break;
                if (item < 256) { const int qb = 31 - (item & 31), bh = q * 8 + (7 - (item >> 5));
#ifndef NO_DIFF
 diff_unit(DA, bh >> 3, bh & 7, qb, lds, tid);
#endif
                } else { const int i2 = item - 256, qb = 63 - (i2 & 63), bg = q * 4 + (3 - (i2 >> 6));
#ifndef NO_NSA
                    if (!cmp_ok) { if (wave == 0) { unsigned sp = 0; while (__builtin_amdgcn_readfirstlane(__hip_atomic_load(ctl + 201, __ATOMIC_RELAXED, __HIP_MEMORY_SCOPE_AGENT)) < 64 * 64) { __builtin_amdgcn_s_sleep(8); if (++sp > (1u << 22)) break; }
                            __builtin_amdgcn_fence(__ATOMIC_ACQUIRE, "agent"); asm volatile("s_waitcnt vmcnt(0)" ::: "memory"); }
                        __syncthreads(); cmp_ok = true; }
 nsa_unit(NA, bg >> 2, bg & 3, qb, lds, tid);
#endif
                }
            }
        }
        CONV_DRAIN();
    }
    SEAM(5);
    if (IN(6)) { PHASE_VARS
        bf16* proj = WSP(bf16, WS_PROJ); bf16* odiff = WSP(bf16, WS_ODIFF); bf16* onsa = WSP(bf16, WS_ONSA); bf16* wbrd_t = WSP(bf16, WS_WBRD); bf16* wbrn_t = WSP(bf16, WS_WBRN); bf16* mixed = WSP(bf16, WS_MIXED);
        { pg8::Gemm g{odiff, wbrd_t, NTOK, DM, DM}; pg8::StaticOrder S; S.init(NTOK, DM, G, bx); EpiBrM E{proj, mixed};
          pg8::gemm_phase<EpiBrM, pg8::StaticOrder, true, true, false, true>(lds, g, S, E, tid); }
    }
    SEAM(6);
    if (IN(7)) { PHASE_VARS
        const float* x = ap->in[0]; bf16* mixed = WSP(bf16, WS_MIXED); bf16* wo_t = WSP(bf16, WS_WO);
        CONV_DRAIN();
        { pg8::Gemm g{mixed, wo_t, NTOK, DM, DM}; pg8::StaticOrder S; S.init(NTOK, DM, G, bx); EpiHpre E{x, WSP(bf16, WS_HPRE)};
          pg8::gemm_phase<EpiHpre, pg8::StaticOrder, true, true>(lds, g, S, E, tid); }
    }
    SEAM(7);
    if (IN(8)) { PHASE_VARS
        bf16* hb = WSP(bf16, WS_HB); int* tope = WSP(int, WS_TOPE); float* gate = WSP(float, WS_GATE); int* posg = WSP(int, WS_POS); int* ctl = WSP(int, WS_CTL);
        LAS float* wl = (LAS float*)lds;
        LAS float* lg = (LAS float*)(lds + 131072 + 512);
        LAS int* lcnt = (LAS int*)(lds + 135168 + 512);
        LAS int* lbase = lcnt + 32;
        LAS int* ent_e = (LAS int*)(lds + 135424 + 512);
        LAS int* ent_lp = ent_e + 512;
        const float* wr = ap->in[21]; const float* br = ap->in[22]; const float* g1 = ap->in[19]; const float* b1 = ap->in[20];
        { int* slot_tok = WSP(int, WS_SLOTTOK); for (size_t i = gtid; i < (size_t)MAXSLOT; i += nthr) slot_tok[i] = 0; }
        for (int i = tid; i < 32768; i += 512) wl[(i & 31) * 1028 + (i >> 5)] = wr[i];
        for (int chunk = bx; chunk < NTOK / 128; chunk += G) {
            if (tid < 32) lcnt[tid] = 0;
            __syncthreads();
            const int row0 = chunk * 128 + wave * 16;
            u32x2 nx[4][4];
#pragma unroll
            for (int r = 0; r < 4; ++r)
#pragma unroll
                for (int j = 0; j < 4; ++j) nx[r][j] = __builtin_nontemporal_load((const u32x2*)(WSP(bf16, WS_HPRE) + (size_t)(row0 + r) * DM + 4 * lane + 256 * j));
            for (int grp = 0; grp < 4; ++grp) {
                float hv[4][16];
#pragma unroll
                for (int r = 0; r < 4; ++r) { const size_t row = (size_t)(row0 + grp * 4 + r);
                    f32x4 v[4]; float s = 0.f;
#pragma unroll
                    for (int j = 0; j < 4; ++j) { v[j] = (f32x4){bflo(nx[r][j].x), bfhi(nx[r][j].x), bflo(nx[r][j].y), bfhi(nx[r][j].y)}; s += (v[j][0] + v[j][1]) + (v[j][2] + v[j][3]); }
                    { const int gn = grp < 3 ? grp + 1 : 3;
#pragma unroll
                      for (int j = 0; j < 4; ++j) nx[r][j] = __builtin_nontemporal_load((const u32x2*)(WSP(bf16, WS_HPRE) + (size_t)(row0 + gn * 4 + r) * DM + 4 * lane + 256 * j)); }
                    const float mean = wave_sum(s) * (1.0f / DM); float s2 = 0.f;
#pragma unroll
                    for (int j = 0; j < 4; ++j) { v[j] = v[j] - mean; s2 += (v[j][0] * v[j][0] + v[j][1] * v[j][1]) + (v[j][2] * v[j][2] + v[j][3] * v[j][3]); }
                    const float rstd = 1.0f / sqrtf(wave_sum(s2) * (1.0f / DM) + LN_EPS);
#pragma unroll
                    for (int j = 0; j < 4; ++j) { const f32x4 gg = *(const f32x4*)(g1 + 256 * j + 4 * lane), bb = *(const f32x4*)(b1 + 256 * j + 4 * lane);
                        const f32x4 h4 = v[j] * rstd * gg + bb;
                        u32x2 hw; hw.x = pk2(h4[0], h4[1]); hw.y = pk2(h4[2], h4[3]); *(u32x2*)(hb + row * DM + 256 * j + 4 * lane) = hw;
                        *(unsigned*)(WSP(unsigned char, WS_HQ) + row * DM + 256 * j + 4 * lane) = pack4_fp8(h4[0], h4[1], h4[2], h4[3]);
                        hv[r][4 * j] = h4[0]; hv[r][4 * j + 1] = h4[1]; hv[r][4 * j + 2] = h4[2]; hv[r][4 * j + 3] = h4[3]; } }
#pragma unroll 1
                for (int ec = 0; ec < 4; ++ec) {
                    float ac[32];
                    { f32x2_t a2[16];
#pragma unroll
                      for (int i = 0; i < 16; ++i) a2[i] = (f32x2_t){0.f, 0.f};
#pragma unroll
                      for (int el = 0; el < 8; ++el)
#pragma unroll
                          for (int j = 0; j < 4; ++j) { const f32x4 w4 = *(const LAS f32x4*)(wl + (8 * ec + el) * 1028 + 256 * j + 4 * lane);
#pragma unroll
                              for (int c4 = 0; c4 < 4; ++c4) { const f32x2_t wv = (f32x2_t){w4[c4], w4[c4]};
                                  a2[2 * el] = __builtin_elementwise_fma((f32x2_t){hv[0][4 * j + c4], hv[1][4 * j + c4]}, wv, a2[2 * el]);
                                  a2[2 * el + 1] = __builtin_elementwise_fma((f32x2_t){hv[2][4 * j + c4], hv[3][4 * j + c4]}, wv, a2[2 * el + 1]); } }
#pragma unroll
                      for (int el = 0; el < 8; ++el) { ac[el * 4] = a2[2 * el].x; ac[el * 4 + 1] = a2[2 * el].y; ac[el * 4 + 2] = a2[2 * el + 1].x; ac[el * 4 + 3] = a2[2 * el + 1].y; } }
#define BFLY(N, OFF, CTRL) _Pragma("unroll") for (int i = 0; i < (N); ++i) { const bool up_ = (lane & (OFF)) != 0; const float send_ = up_ ? ac[i] : ac[i + (N)], keep_ = up_ ? ac[i + (N)] : ac[i]; ac[i] = keep_ + dpp_get<CTRL>(send_); }
#pragma unroll
                    for (int i = 0; i < 16; ++i) { const auto rr = __builtin_amdgcn_permlane32_swap(__float_as_uint(ac[i]), __float_as_uint(ac[i + 16]), false, false); ac[i] = __uint_as_float(rr[0]) + __uint_as_float(rr[1]); }
#pragma unroll
                    for (int i = 0; i < 8; ++i) { const auto rr = __builtin_amdgcn_permlane16_swap(__float_as_uint(ac[i]), __float_as_uint(ac[i + 8]), false, false); ac[i] = __uint_as_float(rr[0]) + __uint_as_float(rr[1]); }
                    BFLY(4, 8, 0x140) BFLY(2, 4, 0x141) BFLY(1, 2, 0x4E)
#undef BFLY
                    const float tot = ac[0] + dpp_get<0xB1>(ac[0]);
                    const int idx = lane >> 1, el = idx >> 2, r = idx & 3;
                    if (!(lane & 1)) lg[(wave * 4 + r) * 32 + 8 * ec + el] = tot + br[8 * ec + el];
                }
#pragma unroll 1
                for (int rr = 0; rr < 4; rr += 2) { const int r = rr + (lane >> 5), e = lane & 31; const LAS float* lr = lg + (wave * 4 + r) * 32;
                    const float v = lr[e]; int rank = 0;
                    for (int j = 0; j < 32; ++j) { const float vj = lr[j]; rank += (vj > v || (vj == v && j < e)) ? 1 : 0; }
                    float vmax = v;
#pragma unroll
                    for (int o = 0; o < 1; ++o) vmax = row16_max(sw16_max(vmax));
                    const float ex = rank < 4 ? __builtin_amdgcn_exp2f((v - vmax) * LOG2E) : 0.f; float s = ex;
#pragma unroll
                    for (int o = 0; o < 1; ++o) s = row16_sum(sw16_sum(s));
                    if (rank < 4) { const int t = row0 + grp * 4 + r; const int lp = __hip_atomic_fetch_add(lcnt + e, 1, __ATOMIC_RELAXED, __HIP_MEMORY_SCOPE_WORKGROUP);
                        const int ix = (t - chunk * 128) * 4 + rank; ent_e[ix] = e; ent_lp[ix] = lp; tope[t * 4 + rank] = e; gate[t * 4 + rank] = ex / s; }
                }
            }
            __syncthreads();
            if (tid < 32) lbase[tid] = __hip_atomic_fetch_add(ctl + tid, lcnt[tid], __ATOMIC_RELAXED, __HIP_MEMORY_SCOPE_AGENT);
            __syncthreads();
            posg[chunk * 512 + tid] = lbase[ent_e[tid]] + ent_lp[tid];
            __syncthreads();
        }
    }
    SEAM(8);
    if (IN(9)) { PHASE_VARS
        bf16* hb = WSP(bf16, WS_HB); bf16* xg = WSP(bf16, WS_XG); int* tope = WSP(int, WS_TOPE); float* gate = WSP(float, WS_GATE); int* posg = WSP(int, WS_POS); int* slot_of = WSP(int, WS_SLOTOF); float* slot_gate = WSP(float, WS_SLOTGATE); int* blk_e = WSP(int, WS_BLKE); int* ctl = WSP(int, WS_CTL);
        LAS int* bst = (LAS int*)lds;
        if (tid == 0) { int acc = 0; for (int e = 0; e < 32; ++e) { bst[e] = acc; acc += (ctl[e] + 255) >> 8; } bst[32] = acc; }
        __syncthreads();
        if (bx == 0) { for (int e = wave; e < 32; e += 8) for (int pm = bst[e] + lane; pm < bst[e + 1]; pm += 64) blk_e[pm] = e;
            if (tid == 0) blk_e[MAXBLK] = bst[32]; }
        { int* slot_tok = WSP(int, WS_SLOTTOK);
          for (size_t as = gtid; as < (size_t)NTOK * 4; as += nthr) { const int t = (int)(as >> 2), e = tope[as]; const int slot = 256 * bst[e] + posg[as];
              slot_of[as] = slot; slot_gate[slot] = gate[as]; slot_tok[slot] = t; } }
    }
    SEAM(9);
    if (IN(10)) { PHASE_VARS
        bf16* xg = WSP(bf16, WS_XG); bf16* we1_t = (bf16*)out; bf16* act = WSP(bf16, WS_ACT); bf16* hb = WSP(bf16, WS_HB); bf16* wpg_t = WSP(bf16, WS_WPG); bf16* ple = WSP(bf16, WS_PLE); int* blk_e = WSP(int, WS_BLKE);
        const int nblk = __builtin_amdgcn_readfirstlane(blk_e[MAXBLK]);
        { pg8::Gemm g{WSP(bf16, WS_HQ), we1_t, nblk * 256, NEXP * 2 * DFF, DM / 2}; GroupedOrder S{blk_e, nblk, 8, G, vcu, 1 << 30, 0}; EpiFfn1T<true> E{act, WSP(bf16, WS_B1H)};
          pg8::gemm_phase<EpiFfn1T<true>, GroupedOrder, true, true, true, true>(lds, g, S, E, tid, WSP(int, WS_SLOTTOK)); }
        { const int c0 = (nblk * 8) % G, nf = c0 ? G - c0 : 0, npg = 512; int n10 = nf + ((npg - nf) / G) * G; if (n10 > npg) n10 = npg;
          pg8::Gemm g{WSP(bf16, WS_HQ), wpg_t, NTOK, DM, DM / 2}; FillOrder S{n10, DM / 256, G, vcu, c0, 0}; EpiPleT<true> E{ple, ap->in[28]};
          pg8::gemm_phase<EpiPleT<true>, FillOrder, true, true, false, true>(lds, g, S, E, tid); }
    }
    SEAM(10);
    if (IN(11)) { PHASE_VARS
        bf16* xg = WSP(bf16, WS_XG); bf16* we2_t = WSP(bf16, WS_WE2A); bf16* act = WSP(bf16, WS_ACT); float* slot_gate = WSP(float, WS_SLOTGATE); int* blk_e = WSP(int, WS_BLKE);
        const int nblk = __builtin_amdgcn_readfirstlane(blk_e[MAXBLK]);
        { pg8::Gemm g{act, we2_t, nblk * 256, NEXP * DM, DFF / 2}; GroupedOrder S{blk_e, nblk, 4, G, vcu, 1 << 30, 0}; EpiFfn2T<true> E{xg, WSP(bf16, WS_B2H)};
          pg8::gemm_phase<EpiFfn2T<true>, GroupedOrder, true, true, false, true>(lds, g, S, E, tid); }
        { const int c0 = (nblk * 8) % G, nf = c0 ? G - c0 : 0, npg = 512; int n10 = nf + ((npg - nf) / G) * G; if (n10 > npg) n10 = npg;
          if (n10 < npg) { pg8::Gemm g{WSP(bf16, WS_HQ), WSP(bf16, WS_WPG), NTOK, DM, DM / 2}; FillOrder S{npg - n10, DM / 256, G, vcu, (nblk * 4) % G, n10}; EpiPleT<true> E{WSP(bf16, WS_PLE), ap->in[28]};
              pg8::gemm_phase<EpiPleT<true>, FillOrder, true, true, false, true>(lds, g, S, E, tid); } }
    }
    SEAM(11);
    if (IN(12)) { PHASE_VARS
        bf16* xg = WSP(bf16, WS_XG); bf16* ple = WSP(bf16, WS_PLE); int* slot_of = WSP(int, WS_SLOTOF); bf16* hb = WSP(bf16, WS_HB);
        const float* g2 = ap->in[30]; const float* b2 = ap->in[31];
        const float* gate = WSP(float, WS_GATE);
        int sraw[4]; float graw[4];
#pragma unroll
        for (int k = 0; k < 4; ++k) { sraw[k] = slot_of[gw * 4 + k]; graw[k] = gate[gw * 4 + k]; }
        for (int t = gw; t < NTOK; t += NGW) {
            float* hp = out + (size_t)t * DM + 4 * lane; f32x4 v[4];
            int sl[4];
#pragma unroll
            for (int k = 0; k < 4; ++k) sl[k] = __builtin_amdgcn_readfirstlane(sraw[k]);
            float gk[4];
#pragma unroll
            for (int k = 0; k < 4; ++k) gk[k] = __builtin_bit_cast(float, __builtin_amdgcn_readfirstlane(__builtin_bit_cast(int, graw[k])));
            { const int tn = t + NGW < NTOK ? t + NGW : t;
#pragma unroll
              for (int k = 0; k < 4; ++k) { sraw[k] = slot_of[tn * 4 + k]; graw[k] = gate[tn * 4 + k]; } }
            float s = 0.f;
#pragma unroll
            for (int j = 0; j < 4; ++j) { { const u32x2 hw = __builtin_nontemporal_load((const u32x2*)(hb + (size_t)t * DM + 256 * j + 4 * lane)); v[j] = (f32x4){bflo(hw.x), bfhi(hw.x), bflo(hw.y), bfhi(hw.y)} * DN_ALPHA; }
                { const u32x2 pw = __builtin_nontemporal_load((const u32x2*)(ple + (size_t)t * DM + 256 * j + 4 * lane)); v[j] += (f32x4){bflo(pw.x), bfhi(pw.x), bflo(pw.y), bfhi(pw.y)}; }
                { f32x4 ys = (f32x4){0.f, 0.f, 0.f, 0.f};
#pragma unroll
                  for (int k = 0; k < 4; ++k) { const int yw = (int)__builtin_nontemporal_load((const unsigned*)((const unsigned char*)xg + (size_t)sl[k] * DM + 256 * j + 4 * lane));
                      const f32x2_t lo = __builtin_amdgcn_cvt_pk_f32_fp8(yw, false), hi = __builtin_amdgcn_cvt_pk_f32_fp8(yw, true); ys += (f32x4){lo.x, lo.y, hi.x, hi.y} * gk[k]; }
                  v[j] += ys * (1.0f / YSCALE); }
                s += (v[j][0] + v[j][1]) + (v[j][2] + v[j][3]); }
            const float mean = wave_sum(s) * (1.0f / DM); float s2 = 0.f;
#pragma unroll
            for (int j = 0; j < 4; ++j) { v[j] = v[j] - mean; s2 += (v[j][0] * v[j][0] + v[j][1] * v[j][1]) + (v[j][2] * v[j][2] + v[j][3] * v[j][3]); }
            const float rstd = 1.0f / sqrtf(wave_sum(s2) * (1.0f / DM) + LN_EPS);
#pragma unroll
            for (int j = 0; j < 4; ++j) { const f32x4 gg = *(const f32x4*)(g2 + 256 * j + 4 * lane), bb = *(const f32x4*)(b2 + 256 * j + 4 * lane); *(f32x4*)(hp + 256 * j) = v[j] * rstd * gg + bb; }
        }
    }
#undef IN
#undef SEAM
}

#ifndef MK_MULTI
#define MK_MULTI 0
#endif
extern "C" void kernel_launch(void* const* d_in, const int* in_sizes, int n_in, void* d_out, int out_size, void* d_ws, size_t ws_size, hipStream_t stream) {
    static int grid = 0;
    if (grid == 0) {
        if (n_in != 32 || out_size != NTOK * DM || ws_size < WS_NEED) { fprintf(stderr, "kernel_launch: unexpected shapes (n_in %d, out %d, ws %zu)\n", n_in, out_size, ws_size); grid = -1; return; }
        int dev = 0, cus = 0, per_cu = 0;
        hipGetDevice(&dev); hipDeviceGetAttribute(&cus, hipDeviceAttributeMultiprocessorCount, dev);
        hipFuncSetAttribute((const void*)mk_fwd, hipFuncAttributeMaxDynamicSharedMemorySize, LDS_BYTES);
        hipOccupancyMaxActiveBlocksPerMultiprocessor(&per_cu, (const void*)mk_fwd, 512, LDS_BYTES);
        (void)hipGetLastError();
        if (per_cu < 1) { fprintf(stderr, "kernel_launch: occupancy query says %d blocks per CU\n", per_cu); per_cu = 1; }
        grid = cus;
        if (grid > cus * per_cu) grid = cus * per_cu;
    }
    if (grid < 0) return;
    hipMemsetAsync((char*)d_ws + WS_CTL, 0, CTL_BYTES, stream);
    Args a{};
    for (int i = 0; i < 32; ++i) a.in[i] = (const float*)d_in[i];
    a.out = (float*)d_out; a.ws = (unsigned char*)d_ws;
#if MK_MULTI
    for (int p = 0; p < NPHASE; ++p) { a.ph_lo = p; a.ph_hi = p + 1; hipLaunchKernelGGL(mk_fwd, dim3(grid), dim3(512), LDS_BYTES, stream, a); }
#else
    a.ph_lo = 0; a.ph_hi = NPHASE;
    void* args[] = {&a};
    hipError_t e = hipLaunchCooperativeKernel((const void*)mk_fwd, dim3(grid), dim3(512), args, LDS_BYTES, stream);
    if (e != hipSuccess) fprintf(stderr, "cooperative launch failed: %s (grid %d)\n", hipGetErrorString(e), grid);
#endif
}
```

```cpp
#include <hip/hip_runtime.h>
#include <hip/hip_cooperative_groups.h>
#include <cstdio>
#include <cstdint>
#include <type_traits>
namespace cg = cooperative_groups;

namespace pg8 {
#define PG8_LAS __attribute__((address_space(3)))
typedef unsigned short bf16_t;
typedef short bf16x8 __attribute__((ext_vector_type(8)));
typedef float f32x4 __attribute__((ext_vector_type(4)));
typedef unsigned u32x4 __attribute__((ext_vector_type(4)));
typedef int i32x4 __attribute__((ext_vector_type(4)));
typedef int i32x8 __attribute__((ext_vector_type(8)));
constexpr int BM = 256, BK = 64, HALF = 128, HTB = HALF * BK * 2  , STAGE_BYTES = 8 * HTB, NXCD = 8, WGM = 8;

__host__ __device__ __forceinline__ int lds_byte(int r, int c) { const int st = (r >> 4) * 2 + (c >> 5), rr = r & 15, cc = c & 31, ob = rr * 64 + cc * 2; return st * 1024 + (ob ^ (((ob >> 9) & 1) << 5)); }
__host__ __device__ __forceinline__ void stage_rc(int b, int& R, int& C) { const int st = b / 1024, sb = b % 1024, swz = sb ^ (((sb >> 9) & 1) << 5); R = (st >> 1) * 16 + swz / 64; C = (st & 1) * 32 + (swz % 64) / 2; }
__host__ __device__ __forceinline__ int perm32(int rho) { const int n = rho >> 4, i = rho & 15; return 8 * (i >> 2) + 4 * n + (i & 3); }

template <class E, class = void> struct HasBias : std::false_type {};
template <class E> struct HasBias<E, std::void_t<decltype(E::BIASINIT)>> : std::true_type {};
struct NoBiasRaw {}; template <class E, class = void> struct BiasRawOf { typedef NoBiasRaw type; };
template <class E> struct BiasRawOf<E, std::void_t<typename E::BiasRaw>> { typedef typename E::BiasRaw type; };
template <class E, class = void> struct HasMid : std::false_type {};
template <class E> struct HasMid<E, std::void_t<decltype(E::MIDK)>> : std::true_type {};
struct Unit { int pm, pn; };
struct Gemm { const bf16_t* A; const bf16_t* Bt; int M, N, K; };

struct StaticOrder {
    int nM, nN, nwg, G, c;
    __host__ __device__ void init(int M, int N, int G_, int c_) { nM = M / BM; nN = N / BM; nwg = nM * nN; G = G_; c = c_; }
    __host__ __device__ bool next(int i, Unit& u) const {
        const long L = (long)i * G + c; if (L >= nwg) return false;
        int wgid = (int)L; { const int q = nwg / NXCD, r = nwg % NXCD, xcd = wgid % NXCD, off = wgid / NXCD; wgid = (xcd < r ? xcd * (q + 1) : r * (q + 1) + (xcd - r) * q) + off; }
        const int nig = WGM * nN, gid = wgid / nig, fm = gid * WGM, gsz = (nM - fm) < WGM ? (nM - fm) : WGM;
        u.pm = fm + ((wgid % nig) % gsz); u.pn = (wgid % nig) / gsz; return true;
    }
};
typedef double f64x2 __attribute__((ext_vector_type(2)));
__device__ __forceinline__ f32x4 zero4() { double a, b; asm volatile("v_mov_b64 %0, 0" : "=v"(a)); asm volatile("v_mov_b64 %0, 0" : "=v"(b)); f64x2 v; v.x = a; v.y = b; return __builtin_bit_cast(f32x4, v); }
__device__ __forceinline__ f32x4 copy4(const f32x4& v) { const f64x2 d = __builtin_bit_cast(f64x2, v); double a, b; asm volatile("v_mov_b64 %0, %1" : "=v"(a) : "v"(d.x)); asm volatile("v_mov_b64 %0, %1" : "=v"(b) : "v"(d.y)); f64x2 r; r.x = a; r.y = b; return __builtin_bit_cast(f32x4, r); }
__device__ __forceinline__ unsigned cvt_pk_bf16(float lo, float hi) { unsigned r; asm volatile("v_cvt_pk_bf16_f32 %0, %1, %2" : "=v"(r) : "v"(lo), "v"(hi)); return r; }

template <class Epi, class Sched, bool ALIGN_EPI = false, bool SP2 = false, bool GATHER = false, bool F8 = false>
__device__ __forceinline__ void gemm_phase(PG8_LAS unsigned char* lds, const Gemm g, const Sched& S, const Epi& E, const int tid, const int* gtab = nullptr) {
    static_assert(!GATHER || SP2, "the gathered A operand is wired into the SP2 loop only");
    const int wid = __builtin_amdgcn_readfirstlane(tid >> 6), lane = tid & 63, wr = wid >> 2, wc = wid & 3, fr = lane & 15, fq = lane >> 4;
    int K_ = g.K; asm volatile("" : "+s"(K_));
    const int K = K_, nt = K / BK;
    unsigned voffA[2], voffB[2];
#pragma unroll
    for (int i = 0; i < 2; ++i) { int R, C; stage_rc(tid * 16 + i * 8192, R, C); const int Rb = Epi::PERM ? ((R & ~31) + perm32(R & 31)) : R;
        voffA[i] = (unsigned)(R * K + C) * 2u; voffB[i] = (unsigned)(Rb * K + C) * 2u; }
    unsigned gc[2][2] = {{0u, 0u}, {0u, 0u}}, gn[2][2] = {{0u, 0u}, {0u, 0u}};
#define PG8_GLOAD(dst, pm_) do { _Pragma("unroll") for (int h_ = 0; h_ < 2; ++h_) _Pragma("unroll") for (int i_ = 0; i_ < 2; ++i_) { int R_, C_; stage_rc(tid * 16 + i_ * 8192, R_, C_); \
        dst[h_][i_] = (unsigned)gtab[(pm_) * BM + h_ * HALF + R_] * (unsigned)(K * 2) + (unsigned)(C_ * 2); } } while (0)
#define PG8_STAGE_A(bufoff, gb_plain, gb_gather, off_g) do { if constexpr (GATHER) { PG8_STAGE(bufoff, gb_gather, off_g); } else { PG8_STAGE(bufoff, gb_plain, voffA); } } while (0)
    const size_t kstep = (size_t)(BK * 2);
    const size_t hstep = (size_t)HALF * K * 2;
    const size_t tstep = 2 * hstep;
    const unsigned ldsw = (unsigned)wid * 1024u;
    const int aoff = lds_byte(wr * 64 + fr, fq * 8), boff = lds_byte(wc * 32 + fr, fq * 8);
#define PG8_SA(b, h) (((b) * 2 + (h)) * HTB)
#define PG8_SB(b, h) ((4 + (b) * 2 + (h)) * HTB)
#define PG8_STAGE(bufoff, gbase, voff) do { _Pragma("unroll") for (int _i = 0; _i < 2; ++_i) \
        __builtin_amdgcn_global_load_lds((const unsigned*)((const char*)(gbase) + (voff)[_i]), (PG8_LAS unsigned*)(lds + (bufoff) + ldsw + _i * 8192), 16, 0, 0); } while (0)
#define PG8_LDA(dst, b, h) do { _Pragma("unroll") for (int m = 0; m < 4; ++m) _Pragma("unroll") for (int k = 0; k < 2; ++k) dst[m][k] = *(const PG8_LAS bf16x8*)(lds + PG8_SA(b, h) + aoff + m * 2048 + k * 1024); } while (0)
#define PG8_LDB(dst, b, h) do { _Pragma("unroll") for (int n = 0; n < 2; ++n) _Pragma("unroll") for (int k = 0; k < 2; ++k) dst[n][k] = *(const PG8_LAS bf16x8*)(lds + PG8_SB(b, h) + boff + n * 2048 + k * 1024); } while (0)
#define PG8_CAT(x) __builtin_shufflevector(__builtin_bit_cast(i32x4, (x)[0]), __builtin_bit_cast(i32x4, (x)[1]), 0, 1, 2, 3, 4, 5, 6, 7)
#define PG8_MMA(ai, bj, At, Bt) do { __builtin_amdgcn_s_setprio(1); if constexpr (F8) { _Pragma("unroll") for (int m = 0; m < 4; ++m) _Pragma("unroll") for (int n = 0; n < 2; ++n) \
        asm volatile("v_mfma_scale_f32_16x16x128_f8f6f4 %0, %1, %2, %0, %3, %3 op_sel_hi:[0,0,0]" : "+v"(acc[ai][bj][m][n]) : "v"(PG8_CAT(Bt[n])), "v"(PG8_CAT(At[m])), "v"(f8sc)); } else { \
        _Pragma("unroll") for (int m = 0; m < 4; ++m) _Pragma("unroll") for (int n = 0; n < 2; ++n) _Pragma("unroll") for (int k = 0; k < 2; ++k) \
        acc[ai][bj][m][n] = __builtin_amdgcn_mfma_f32_16x16x32_bf16(Bt[n][k], At[m][k], acc[ai][bj][m][n], 0, 0, 0); } __builtin_amdgcn_s_setprio(0); } while (0)
#define PG8_WAIT_V(n) asm volatile("s_waitcnt vmcnt(" #n ")" ::: "memory")
#define PG8_WAIT_L(n) asm volatile("s_waitcnt lgkmcnt(" #n ")" ::: "memory")
#define PG8_BAR __builtin_amdgcn_s_barrier()
#define PG8_SCHED __builtin_amdgcn_sched_barrier(0)
    Unit cur, nxt; int ui = 0;
    if (!S.next(0, cur)) return;
    const int f8sc = 0x7f7f7f7f;
    f32x4 acc[2][2][4][2];
#pragma unroll
    for (int a = 0; a < 2; ++a)
#pragma unroll
        for (int b = 0; b < 2; ++b)
#pragma unroll
            for (int m = 0; m < 4; ++m)
#pragma unroll
                for (int n = 0; n < 2; ++n) acc[a][b][m][n] = zero4();
    if constexpr (HasBias<Epi>::value) { typename Epi::BiasRaw pb0_; f32x4 b0_[2][2]; E.bias(cur, wc, fq, pb0_); E.binit(pb0_, b0_);
        _Pragma("unroll") for (int a = 0; a < 2; ++a) _Pragma("unroll") for (int b = 0; b < 2; ++b) _Pragma("unroll") for (int m = 0; m < 4; ++m) _Pragma("unroll") for (int n = 0; n < 2; ++n) acc[a][b][m][n] = b0_[b][n]; }
    bf16x8 At[4][2], B0[2][2], B1[2][2];
    const char* cA = (const char*)g.A + (size_t)cur.pm * tstep; const char* cB = (const char*)g.Bt + (size_t)cur.pn * tstep;
    const char* const gA0 = (const char*)g.A;
    if constexpr (GATHER) { PG8_GLOAD(gc, cur.pm); }

    if constexpr (SP2) {
        PG8_STAGE(PG8_SB(0, 0), cB, voffB); PG8_STAGE(PG8_SB(0, 1), cB + hstep, voffB); PG8_STAGE_A(PG8_SA(0, 0), cA, gA0, gc[0]); PG8_STAGE_A(PG8_SA(0, 1), cA + hstep, gA0, gc[1]);
        if (wr == 1) PG8_BAR;
        PG8_WAIT_V(2); PG8_BAR;
        PG8_STAGE(PG8_SB(1, 0), cB + kstep, voffB); PG8_STAGE_A(PG8_SA(1, 0), cA + kstep, gA0 + kstep, gc[0]); PG8_STAGE(PG8_SB(1, 1), cB + hstep + kstep, voffB);
        PG8_WAIT_V(6); PG8_BAR;
    } else {
        PG8_STAGE(PG8_SB(0, 0), cB, voffB); PG8_STAGE(PG8_SA(0, 0), cA, voffA); PG8_STAGE(PG8_SB(0, 1), cB + hstep, voffB); PG8_STAGE(PG8_SA(0, 1), cA + hstep, voffA);
        if (wr == 1) PG8_BAR;
        PG8_WAIT_V(4); PG8_BAR;
        PG8_STAGE(PG8_SB(1, 0), cB + kstep, voffB); PG8_STAGE(PG8_SA(1, 0), cA + kstep, voffA); PG8_STAGE(PG8_SB(1, 1), cB + hstep + kstep, voffB);
        PG8_WAIT_V(6); PG8_BAR;
    }
    for (;;) {
        const bool has_next = S.next(ui + 1, nxt);
        const char* nA = has_next ? (const char*)g.A + (size_t)nxt.pm * tstep : cA; const char* nB = has_next ? (const char*)g.Bt + (size_t)nxt.pn * tstep : cB;
        if constexpr (GATHER) { if (has_next) { PG8_GLOAD(gn, nxt.pm); } else { _Pragma("unroll") for (int h_ = 0; h_ < 2; ++h_) _Pragma("unroll") for (int i_ = 0; i_ < 2; ++i_) gn[h_][i_] = gc[h_][i_]; } }
        for (int t = 0; t < nt; t += 2) {
            if constexpr (HasMid<Epi>::value) { if (t == (nt >> 1)) E.mid(acc, cur, wr, wc, fr, fq); }
            const bool last = (t == nt - 2);
            const char* a1 = cA + (size_t)(t + 1) * kstep;
            const char* a2 = last ? nA : cA + (size_t)(t + 2) * kstep; const char* b2 = last ? nB : cB + (size_t)(t + 2) * kstep;
            const char* a3 = a2 + kstep; const char* b3 = b2 + kstep;

            if constexpr (SP2) {
            const char* g2 = gA0 + (last ? (size_t)0 : (size_t)(t + 2) * kstep);
            unsigned gs0[2], gs1[2]; gs0[0] = last ? gn[0][0] : gc[0][0]; gs0[1] = last ? gn[0][1] : gc[0][1]; gs1[0] = last ? gn[1][0] : gc[1][0]; gs1[1] = last ? gn[1][1] : gc[1][1];
            PG8_LDB(B0, 0, 0); PG8_LDB(B1, 0, 1); PG8_SCHED; PG8_LDA(At, 0, 0); PG8_STAGE_A(PG8_SA(1, 1), a1 + hstep, gA0 + (size_t)(t + 1) * kstep, gc[1]);
            PG8_WAIT_V(8); PG8_WAIT_L(0); PG8_BAR; PG8_MMA(0, 0, At, B0); PG8_MMA(0, 1, At, B1); PG8_BAR; PG8_SCHED;
            PG8_LDA(At, 0, 1); PG8_STAGE(PG8_SB(0, 0), b2, voffB); PG8_STAGE(PG8_SB(0, 1), b2 + hstep, voffB); PG8_STAGE_A(PG8_SA(0, 0), a2, g2, gs0);
            PG8_WAIT_V(8); PG8_WAIT_L(0); PG8_BAR; PG8_MMA(1, 0, At, B0); PG8_MMA(1, 1, At, B1); PG8_BAR; PG8_SCHED;
            PG8_LDB(B0, 1, 0); PG8_LDB(B1, 1, 1); PG8_SCHED; PG8_LDA(At, 1, 0); PG8_STAGE_A(PG8_SA(0, 1), a2 + hstep, g2, gs1);
            PG8_WAIT_V(8); PG8_WAIT_L(0); PG8_BAR; PG8_MMA(0, 0, At, B0); PG8_MMA(0, 1, At, B1); PG8_BAR; PG8_SCHED;
            PG8_LDA(At, 1, 1); PG8_STAGE(PG8_SB(1, 0), b3, voffB); PG8_STAGE(PG8_SB(1, 1), b3 + hstep, voffB); PG8_STAGE_A(PG8_SA(1, 0), a3, g2 + kstep, gs0);
            PG8_WAIT_V(8); PG8_WAIT_L(0); PG8_BAR; PG8_MMA(1, 0, At, B0); PG8_MMA(1, 1, At, B1); PG8_BAR; PG8_SCHED;
            } else {
            PG8_LDB(B0, 0, 0); PG8_SCHED; PG8_LDA(At, 0, 0); PG8_STAGE(PG8_SA(1, 1), a1 + hstep, voffA);
            PG8_WAIT_L(8); PG8_BAR; PG8_WAIT_L(0); PG8_MMA(0, 0, At, B0); PG8_BAR; PG8_SCHED;
            PG8_LDB(B1, 0, 1); PG8_STAGE(PG8_SB(0, 0), b2, voffB);
            PG8_BAR; PG8_WAIT_L(0); PG8_MMA(0, 1, At, B1); PG8_BAR;
            PG8_LDA(At, 0, 1); PG8_STAGE(PG8_SA(0, 0), a2, voffA);
            PG8_BAR; PG8_WAIT_L(0); PG8_MMA(1, 0, At, B0); PG8_BAR; PG8_SCHED;
            PG8_STAGE(PG8_SB(0, 1), b2 + hstep, voffB);
            PG8_WAIT_V(6); PG8_BAR; PG8_MMA(1, 1, At, B1); PG8_BAR;
            PG8_LDB(B0, 1, 0); PG8_SCHED; PG8_LDA(At, 1, 0); PG8_STAGE(PG8_SA(0, 1), a2 + hstep, voffA);
            PG8_WAIT_L(8); PG8_BAR; PG8_WAIT_L(0); PG8_MMA(0, 0, At, B0); PG8_BAR; PG8_SCHED;
            PG8_LDB(B1, 1, 1); PG8_STAGE(PG8_SB(1, 0), b3, voffB);
            PG8_BAR; PG8_WAIT_L(0); PG8_MMA(0, 1, At, B1); PG8_BAR;
            PG8_LDA(At, 1, 1); PG8_STAGE(PG8_SA(1, 0), a3, voffA);
            PG8_BAR; PG8_WAIT_L(0); PG8_MMA(1, 0, At, B0); PG8_BAR; PG8_SCHED;
            PG8_STAGE(PG8_SB(1, 1), b3 + hstep, voffB);
            PG8_WAIT_V(6); PG8_BAR; PG8_MMA(1, 1, At, B1); PG8_BAR;
            }
        }
        if constexpr (F8) asm volatile("s_nop 15\n\ts_nop 15" ::: "memory");
        if constexpr (ALIGN_EPI) { if (wr == 0) PG8_BAR; }
        typename BiasRawOf<Epi>::type npb_;
        if constexpr (HasBias<Epi>::value) E.epi2(acc, cur, wr, wc, fr, fq, nxt, has_next, npb_);
        else E(acc, cur, wr, wc, fr, fq);
        if (!has_next) break;
        f32x4 nb_[2][2]; if constexpr (HasBias<Epi>::value) E.binit(npb_, nb_);
#pragma unroll
        for (int a = 0; a < 2; ++a)
#pragma unroll
            for (int b = 0; b < 2; ++b)
#pragma unroll
                for (int m = 0; m < 4; ++m)
#pragma unroll
                    for (int n = 0; n < 2; ++n) { if constexpr (HasBias<Epi>::value) acc[a][b][m][n] = copy4(nb_[b][n]); else acc[a][b][m][n] = zero4(); }
        cur = nxt; cA = nA; cB = nB; ++ui;
        if constexpr (GATHER) { _Pragma("unroll") for (int h_ = 0; h_ < 2; ++h_) _Pragma("unroll") for (int i_ = 0; i_ < 2; ++i_) gc[h_][i_] = gn[h_][i_]; }
        if constexpr (ALIGN_EPI) { if (wr == 1) PG8_BAR; }
    }
    PG8_WAIT_V(0);
    if constexpr (!ALIGN_EPI) { if (wr == 0) PG8_BAR; }
    PG8_BAR;

#undef PG8_SA
#undef PG8_SB
#undef PG8_STAGE
#undef PG8_STAGE_A
#undef PG8_GLOAD
#undef PG8_LDA
#undef PG8_LDB
#undef PG8_MMA
#undef PG8_CAT
#undef PG8_WAIT_V
#undef PG8_WAIT_L
#undef PG8_BAR
#undef PG8_SCHED
}
}

#define DI __device__ __forceinline__
#define LAS __attribute__((address_space(3)))
typedef unsigned short bf16;
typedef short bf16x8 __attribute__((ext_vector_type(8)));
typedef short s16x4 __attribute__((ext_vector_type(4)));
typedef float f32x4 __attribute__((ext_vector_type(4)));
typedef float f32x16 __attribute__((ext_vector_type(16)));
typedef unsigned u32x4 __attribute__((ext_vector_type(4)));
typedef unsigned u32x2 __attribute__((ext_vector_type(2)));
typedef float f32x2_t __attribute__((ext_vector_type(2)));
typedef __bf16 bf16x2_t __attribute__((ext_vector_type(2)));

DI float bf2f(unsigned b) { return __uint_as_float(b << 16); }
DI float bflo(unsigned w) { return __uint_as_float(w << 16); }
DI float bfhi(unsigned w) { return __uint_as_float(w & 0xffff0000u); }
DI unsigned pk2(float lo, float hi) { f32x2_t v = {lo, hi}; bf16x2_t b = __builtin_convertvector(v, bf16x2_t); return __builtin_bit_cast(unsigned, b); }
DI float sigmoid_f(float v) { return __builtin_amdgcn_rcpf(1.0f + __builtin_amdgcn_exp2f(-1.4426950408889634f * v)); }
DI u32x4 pack8(f32x4 a, f32x4 b) { u32x4 w; w.x = pk2(a[0], a[1]); w.y = pk2(a[2], a[3]); w.z = pk2(b[0], b[1]); w.w = pk2(b[2], b[3]); return w; }
DI void unpack8(u32x4 w, f32x4& a, f32x4& b) { a = (f32x4){bflo(w.x), bfhi(w.x), bflo(w.y), bfhi(w.y)}; b = (f32x4){bflo(w.z), bfhi(w.z), bflo(w.w), bfhi(w.w)}; }

template <int CTRL> DI float dpp_get(float x) { return __builtin_bit_cast(float, __builtin_amdgcn_update_dpp(0, __builtin_bit_cast(int, x), CTRL, 0xf, 0xf, false)); }
DI float row16_sum(float v) { v += dpp_get<0xB1>(v); v += dpp_get<0x4E>(v); v += dpp_get<0x141>(v); v += dpp_get<0x140>(v); return v; }
DI float row16_max(float v) { v = fmaxf(v, dpp_get<0xB1>(v)); v = fmaxf(v, dpp_get<0x4E>(v)); v = fmaxf(v, dpp_get<0x141>(v)); v = fmaxf(v, dpp_get<0x140>(v)); return v; }
DI float sw16_sum(float v) { const auto rr = __builtin_amdgcn_permlane16_swap(__float_as_uint(v), __float_as_uint(v), false, false); return __uint_as_float(rr[0]) + __uint_as_float(rr[1]); }
DI float sw16_max(float v) { const auto rr = __builtin_amdgcn_permlane16_swap(__float_as_uint(v), __float_as_uint(v), false, false); return fmaxf(__uint_as_float(rr[0]), __uint_as_float(rr[1])); }
DI float sw32_sum(float v) { const auto rr = __builtin_amdgcn_permlane32_swap(__float_as_uint(v), __float_as_uint(v), false, false); return __uint_as_float(rr[0]) + __uint_as_float(rr[1]); }
DI float sw32_max(float v) { const auto rr = __builtin_amdgcn_permlane32_swap(__float_as_uint(v), __float_as_uint(v), false, false); return fmaxf(__uint_as_float(rr[0]), __uint_as_float(rr[1])); }

constexpr int BATCH = 8, SEQ = 4096, DM = 1024, NTOK = BATCH * SEQ;
constexpr int PN = 7936;
constexpr int DQ_OFF = 0, DK_OFF = 1024, DV_OFF = 2048, NQ_OFF = 3072, KC_OFF = 4096, VC_OFF = 4352, KS_OFF = 4608, VS_OFF = 4864, KW_OFF = 5120, VW_OFF = 5376, NG_OFF = 5632, MG_OFF = 5888;
constexpr int CIN = 5680;
constexpr float LOG2E = 1.4426950408889634f;
constexpr float QSCALE = 0.125f * LOG2E;
constexpr float LN_EPS = 1e-5f;
constexpr float DN_ALPHA = 1.189207115002721f;
constexpr float LAMBDA_INIT = 0.2f;
constexpr int NEXP = 32, TOPK = 4, DFF = 1024;
constexpr int MAXBLK = (NTOK * TOPK) / 256 + NEXP;
constexpr int MAXSLOT = MAXBLK * 256;
constexpr float ODSCALE = 4.0f, ONSCALE = 8.0f;
constexpr float YSCALE = 64.0f;
constexpr float W2SCALE = 64.0f, ACTSCALE = 4.0f;
constexpr float W1SCALE = 64.0f;
DI unsigned pack4_fp8(float a, float b, float c, float d) { int w = __builtin_amdgcn_cvt_pk_fp8_f32(a, b, 0, false); w = __builtin_amdgcn_cvt_pk_fp8_f32(c, d, w, true); return (unsigned)w; }
DI u32x4 widen_rows(u32x2 a, u32x2 b) { const auto rx = __builtin_amdgcn_permlane16_swap(a.x, b.x, false, false), ry = __builtin_amdgcn_permlane16_swap(a.y, b.y, false, false);
    u32x4 o; o.x = rx[0]; o.y = ry[0]; o.z = rx[1]; o.w = ry[1]; return o; }

#define EPI_ARGS const pg8::f32x4 (&acc)[2][2][4][2], const pg8::Unit& u, int wr, int wc, int fr, int fq
#define EPI_PIN asm volatile("" : "+v"(fr), "+v"(fq));
#define EPI_ROWS _Pragma("unroll") for (int ai = 0; ai < 2; ++ai) _Pragma("unroll") for (int m = 0; m < 4; ++m)
#define EPI_ROW (u.pm * 256 + ai * 128 + wr * 64 + m * 16 + fr)

template <bool F8> struct EpiProjT {
    static constexpr bool PERM = true; static constexpr float ASC = F8 ? (1.0f / W1SCALE) : 1.0f;
    bf16* O; const float* bias; int pn0; int* kn2;
    DI void operator()(EPI_ARGS) const { EPI_PIN
        const int pn = (F8 && u.pn >= 8) ? (u.pn < 12 ? u.pn : NG_OFF / 256) : u.pn + pn0;   const int colt = pn * 256; const int mode = (pn < 4 || (pn >= 12 && pn < 16)) ? 1 : (pn >= 22 ? 2 : 0);
        const int cl = wc * 32 + 8 * fq;
        f32x4 bv[2][2];
#pragma unroll
        for (int bj = 0; bj < 2; ++bj)
#pragma unroll
            for (int n = 0; n < 2; ++n) bv[bj][n] = *(const f32x4*)(bias + colt + bj * 128 + cl + 4 * n);
        float kmx[2] = {0.f, 0.f};
        EPI_ROWS { bf16* rowp = O + (size_t)EPI_ROW * PN + colt + cl;
#pragma unroll
            for (int bj = 0; bj < 2; ++bj) { f32x4 v0 = acc[ai][bj][m][0] * ASC + bv[bj][0], v1 = acc[ai][bj][m][1] * ASC + bv[bj][1];
                if constexpr (!F8) { if (pn >= 4 && pn < 8) {
                    const u32x4 w = pack8(v0, v1); float s2 = 0.f;
#pragma unroll
                    for (int j = 0; j < 4; ++j) { const float a = bflo(w[j]), c2 = bfhi(w[j]); s2 += a * a + c2 * c2; }
                    s2 = sw16_sum(s2); s2 = sw32_sum(s2); kmx[bj] = fmaxf(kmx[bj], s2); } }
                if (mode == 1) { v0 = v0 * QSCALE; v1 = v1 * QSCALE; }
                if (mode == 2) {
#pragma unroll
                    for (int i = 0; i < 4; ++i) { v0[i] = sigmoid_f(v0[i]); v1[i] = sigmoid_f(v1[i]); } }
                __builtin_nontemporal_store(pack8(v0, v1), (u32x4*)(rowp + bj * 128)); } }
        if constexpr (!F8) { if (pn >= 4 && pn < 8) {
#pragma unroll
            for (int bj = 0; bj < 2; ++bj) { float v = kmx[bj];
#pragma unroll
                for (int o_ = 0; o_ < 1; ++o_) v = row16_max(v);
                if (fr == 0 && fq == 0) __hip_atomic_fetch_max(kn2 + (((u.pm >> 4) * 16 + ((pn - 4) * 2 + bj) * 2 + (wc >> 1)) * 2 + (wc & 1)), __builtin_bit_cast(int, v), __ATOMIC_RELAXED, __HIP_MEMORY_SCOPE_AGENT); } } }
    }
};
template <int ACT, bool NT = false> struct EpiBf16 {
    static constexpr bool PERM = true;
    bf16* O; int ldc; int local_pn;
    DI void operator()(EPI_ARGS) const { EPI_PIN
        const int colt = local_pn ? 0 : u.pn * 256; const int cl = wc * 32 + 8 * fq;
        EPI_ROWS { bf16* rowp = O + (size_t)EPI_ROW * ldc + colt + cl;
#pragma unroll
            for (int bj = 0; bj < 2; ++bj) { f32x4 v0 = acc[ai][bj][m][0], v1 = acc[ai][bj][m][1];
                if (ACT == 1) {
#pragma unroll
                    for (int i = 0; i < 4; ++i) { v0[i] = v0[i] * sigmoid_f(v0[i]); v1[i] = v1[i] * sigmoid_f(v1[i]); } }
                if (NT) __builtin_nontemporal_store(pack8(v0, v1), (u32x4*)(rowp + bj * 128)); else *(u32x4*)(rowp + bj * 128) = pack8(v0, v1); } }
    }
};
struct EpiBrM {
    static constexpr bool PERM = true, MIDK = true; static constexpr float ASC1 = 1.0f / (W1SCALE * ODSCALE), ASC2 = 1.0f / (W1SCALE * ONSCALE);
    const bf16* proj; bf16* MX;
    DI void mid(pg8::f32x4 (&acc)[2][2][4][2], const pg8::Unit& u, int wr, int wc, int fr, int fq) const { EPI_PIN
        const int cl = u.pn * 256 + wc * 32 + 8 * fq;
        EPI_ROWS { const size_t row = EPI_ROW;
#pragma unroll
            for (int bj = 0; bj < 2; ++bj) { const int col = cl + bj * 128;
                const u32x4 ga = __builtin_nontemporal_load((const u32x4*)(proj + row * PN + MG_OFF + col)), gb = *(const u32x4*)(proj + row * PN + MG_OFF + DM + col);
                f32x4 a0, a1, b0, b1; unpack8(ga, a0, a1); unpack8(gb, b0, b1);
#pragma unroll
                for (int i = 0; i < 4; ++i) { a0[i] = a0[i] * (ASC1 / ASC2) * __builtin_amdgcn_rcpf(fmaxf(b0[i], 1e-30f)); a1[i] = a1[i] * (ASC1 / ASC2) * __builtin_amdgcn_rcpf(fmaxf(b1[i], 1e-30f)); }
                acc[ai][bj][m][0] = acc[ai][bj][m][0] * a0; acc[ai][bj][m][1] = acc[ai][bj][m][1] * a1; } }
    }
    DI void operator()(EPI_ARGS) const { EPI_PIN
        const int cl = u.pn * 256 + wc * 32 + 8 * fq;
        EPI_ROWS { const size_t row = EPI_ROW;
#pragma unroll
            for (int bj = 0; bj < 2; ++bj) { const int col = cl + bj * 128;
                const u32x4 g = __builtin_nontemporal_load((const u32x4*)(proj + row * PN + MG_OFF + DM + col)); f32x4 g0, g1; unpack8(g, g0, g1);
                *(u32x4*)(MX + row * DM + col) = pack8(acc[ai][bj][m][0] * (g0 * ASC2), acc[ai][bj][m][1] * (g1 * ASC2)); } }
    }
};
struct EpiHpre {
    static constexpr bool PERM = true;
    const bf16* X; bf16* H;
    DI void operator()(EPI_ARGS) const { EPI_PIN
        const int cl = u.pn * 256 + wc * 32 + 8 * fq;
        EPI_ROWS { const size_t row = EPI_ROW;
#pragma unroll
            for (int bj = 0; bj < 2; ++bj) { const size_t off = row * DM + cl + bj * 128;
                const u32x4 xw = __builtin_nontemporal_load((const u32x4*)(X + off)); f32x4 x0, x1; unpack8(xw, x0, x1);
                *(u32x4*)(H + off) = pack8(x0 * DN_ALPHA + acc[ai][bj][m][0], x1 * DN_ALPHA + acc[ai][bj][m][1]); } }
    }
};
template <bool F8> struct EpiPleT {
    static constexpr bool PERM = true; static constexpr float ASC = F8 ? (1.0f / W1SCALE) : 1.0f;
    bf16* T2; const float* bias;
    DI void operator()(EPI_ARGS) const { EPI_PIN
        const int cl = u.pn * 256 + wc * 32 + 8 * fq;
        f32x4 bv[2][2];
#pragma unroll
        for (int bj = 0; bj < 2; ++bj)
#pragma unroll
            for (int n = 0; n < 2; ++n) bv[bj][n] = *(const f32x4*)(bias + cl + bj * 128 + 4 * n);
        EPI_ROWS { const size_t row = EPI_ROW;
#pragma unroll
            for (int bj = 0; bj < 2; ++bj) { bf16* tp = T2 + row * DM + cl + bj * 128;
                const u32x4 t = __builtin_nontemporal_load((const u32x4*)tp); f32x4 t0, t1; unpack8(t, t0, t1);
                f32x4 v0 = acc[ai][bj][m][0] * ASC + bv[bj][0], v1 = acc[ai][bj][m][1] * ASC + bv[bj][1];
#pragma unroll
                for (int i = 0; i < 4; ++i) { v0[i] = sigmoid_f(v0[i]) * t0[i]; v1[i] = sigmoid_f(v1[i]) * t1[i]; }
                *(u32x4*)tp = pack8(v0, v1); } }
    }
};
template <bool F8> struct EpiFfn1T {
    static constexpr bool PERM = true; static constexpr float ASC = F8 ? (1.0f / W1SCALE) : 1.0f, LS = F8 ? ACTSCALE : 1.0f;
    bf16* ACT; const bf16* b1h;
    static constexpr bool BIASINIT = true; struct BiasRaw { u32x4 v[2]; };
    DI void bias(const pg8::Unit& u, int wc, int fq, BiasRaw& raw) const { asm volatile("" : "+v"(fq));
        const int e = u.pn >> 3, pnl = u.pn & 7; const bf16* bp = b1h + (size_t)e * 2 * DFF + pnl * 128 + wc * 32 + 8 * fq;
        raw.v[0] = *(const u32x4*)bp; raw.v[1] = *(const u32x4*)(bp + DFF); }
    DI void binit(const BiasRaw& raw, pg8::f32x4 (&b)[2][2]) const { f32x4 t0, t1;
        unpack8(raw.v[0], t0, t1); b[0][0] = t0 * (1.0f / ASC); b[0][1] = t1 * (1.0f / ASC);
        unpack8(raw.v[1], t0, t1); b[1][0] = (t0 + 1.0f) * (1.0f / ASC); b[1][1] = (t1 + 1.0f) * (1.0f / ASC); }
    template <int AI> DI void rows(const pg8::f32x4 (&acc)[2][2][4][2], const pg8::Unit& u, int wr, int wc, int fr, int fq) const {
        constexpr int ai = AI; const int pnl = u.pn & 7; const int cl = pnl * 128 + wc * 32 + 8 * fq;
        u32x2 keep8 = {0u, 0u};
#pragma unroll
        for (int m = 0; m < 4; ++m) { const size_t row = EPI_ROW;
            f32x4 g0 = acc[ai][0][m][0] * ASC, g1 = acc[ai][0][m][1] * ASC, l0 = acc[ai][1][m][0] * (ASC * LS), l1 = acc[ai][1][m][1] * (ASC * LS);
#define SWIGLU2(G, L, i_) do { const f32x2_t a2 = (f32x2_t){fminf(G[i_], 7.0f), fminf(G[(i_) + 1], 7.0f)}; \
                const f32x2_t b2 = (f32x2_t){__builtin_amdgcn_fmed3f(L[i_], -6.0f * LS, 8.0f * LS), __builtin_amdgcn_fmed3f(L[(i_) + 1], -6.0f * LS, 8.0f * LS)}; \
                const f32x2_t t2 = a2 * (-1.702f * 1.4426950408889634f); f32x2_t d2 = (f32x2_t){__builtin_amdgcn_exp2f(t2.x), __builtin_amdgcn_exp2f(t2.y)} + 1.0f; \
                const f32x2_t r2 = (f32x2_t){__builtin_amdgcn_rcpf(d2.x), __builtin_amdgcn_rcpf(d2.y)}; const f32x2_t o2 = (a2 * r2) * b2; G[i_] = o2.x; G[(i_) + 1] = o2.y; } while (0)
            SWIGLU2(g0, l0, 0); SWIGLU2(g0, l0, 2); SWIGLU2(g1, l1, 0); SWIGLU2(g1, l1, 2);
#undef SWIGLU2
            if constexpr (F8) { u32x2 o8; o8.x = pack4_fp8(g0[0], g0[1], g0[2], g0[3]); o8.y = pack4_fp8(g1[0], g1[1], g1[2], g1[3]);
                if ((m & 1) == 0) keep8 = o8;
                else { const size_t row2 = (size_t)(u.pm * 256 + ai * 128 + wr * 64 + (m - 1 + (fq & 1)) * 16 + fr);
                       *(u32x4*)((unsigned char*)ACT + row2 * DFF + pnl * 128 + wc * 32 + 16 * (fq >> 1)) = widen_rows(keep8, o8); } }
            else *(u32x4*)(ACT + row * DFF + cl) = pack8(g0, g1); }
    }
    DI void epi2(const pg8::f32x4 (&acc)[2][2][4][2], const pg8::Unit& u, int wr, int wc, int fr, int fq, const pg8::Unit& nx, bool has_next, BiasRaw& raw) const { EPI_PIN
        rows<0>(acc, u, wr, wc, fr, fq);
        __builtin_amdgcn_sched_barrier(0);
        if (has_next) bias(nx, wc, fq, raw);
        __builtin_amdgcn_sched_barrier(0);
        rows<1>(acc, u, wr, wc, fr, fq);
    }
    DI void operator()(EPI_ARGS) const { EPI_PIN rows<0>(acc, u, wr, wc, fr, fq); rows<1>(acc, u, wr, wc, fr, fq); }
};
template <bool F8> struct EpiFfn2T {
    static constexpr bool PERM = true; static constexpr float ASC = F8 ? 1.0f / (W2SCALE * ACTSCALE) : 1.0f;
    bf16* Y; const bf16* b2h;
    static constexpr bool BIASINIT = true; struct BiasRaw { u32x4 v[2]; };
    DI void bias(const pg8::Unit& u, int wc, int fq, BiasRaw& raw) const { asm volatile("" : "+v"(fq));
        const int e = u.pn >> 2, pnl = u.pn & 3; const bf16* bp = b2h + (size_t)e * DM + pnl * 256 + wc * 32 + 8 * fq;
        raw.v[0] = *(const u32x4*)bp; raw.v[1] = *(const u32x4*)(bp + 128); }
    DI void binit(const BiasRaw& raw, pg8::f32x4 (&b)[2][2]) const { f32x4 t0, t1;
        unpack8(raw.v[0], t0, t1); b[0][0] = t0 * (1.0f / ASC); b[0][1] = t1 * (1.0f / ASC);
        unpack8(raw.v[1], t0, t1); b[1][0] = t0 * (1.0f / ASC); b[1][1] = t1 * (1.0f / ASC); }
    template <int AI> DI void rows(const pg8::f32x4 (&acc)[2][2][4][2], const pg8::Unit& u, int wr, int wc, int fr, int fq) const {
        constexpr int ai = AI; const int pnl = u.pn & 3; const int cl = pnl * 256 + wc * 32 + 8 * fq;
        u32x2 keep8[2] = {{0u, 0u}, {0u, 0u}};
#pragma unroll
        for (int m = 0; m < 4; ++m) { const size_t row = EPI_ROW; const float gs = ASC * (F8 ? YSCALE : 1.0f);
#pragma unroll
            for (int bj = 0; bj < 2; ++bj) { const f32x4 y0 = acc[ai][bj][m][0] * gs, y1 = acc[ai][bj][m][1] * gs;
                if constexpr (F8) { u32x2 o8; o8.x = pack4_fp8(y0[0], y0[1], y0[2], y0[3]); o8.y = pack4_fp8(y1[0], y1[1], y1[2], y1[3]);
                    if ((m & 1) == 0) keep8[bj] = o8;
                    else { const size_t row2 = (size_t)(u.pm * 256 + ai * 128 + wr * 64 + (m - 1 + (fq & 1)) * 16 + fr);
                           *(u32x4*)((unsigned char*)Y + row2 * DM + pnl * 256 + wc * 32 + 16 * (fq >> 1) + bj * 128) = widen_rows(keep8[bj], o8); } }
                else *(u32x4*)(Y + row * DM + cl + bj * 128) = pack8(y0, y1); } }
    }
    DI void epi2(const pg8::f32x4 (&acc)[2][2][4][2], const pg8::Unit& u, int wr, int wc, int fr, int fq, const pg8::Unit& nx, bool has_next, BiasRaw& raw) const { EPI_PIN
        rows<0>(acc, u, wr, wc, fr, fq);
        __builtin_amdgcn_sched_barrier(0);
        if (has_next) bias(nx, wc, fq, raw);
        __builtin_amdgcn_sched_barrier(0);
        rows<1>(acc, u, wr, wc, fr, fq);
    }
};

struct OneUnit { int pm, pn; DI bool next(int i, pg8::Unit& u) const { if (i > 0) return false; u.pm = pm; u.pn = pn; return true; } };
struct ListOrder {
    int n, per, G, c;
    DI bool next(int i, pg8::Unit& u) const { const int L = i * G + c; if (L >= n) return false; u.pm = L; u.pn = L / per; return true; }
};
struct TailOrder {
    int n, nN, G, c;
    DI bool next(int i, pg8::Unit& u) const { if (c < 0) return false; const int L = i * G + c; if (L >= n) return false; u.pm = L / nN; u.pn = L % nN; return true; }
};
struct FillOrder {
    int n, nN, G, c, c0, base;
    DI bool next(int i, pg8::Unit& u) const { const int nf = c0 ? G - c0 : 0; int p;
        if (c0 && c >= c0) p = (i == 0) ? c - c0 : nf + (i - 1) * G + c; else p = nf + i * G + c;
        if (p >= n) return false; p += base; u.pm = p / nN; u.pn = p % nN; return true; }
};
struct GroupedOrder {
    const int* blk_e; int nblk, NT, G, c;
    int gap_e, gap_pn;
    DI bool next(int i, pg8::Unit& u) const { const long L = (long)i * G + c; if (L >= (long)nblk * NT) return false; const int pm = (int)(L / NT), pnl = (int)(L % NT);
        const int e = __builtin_amdgcn_readfirstlane(blk_e[pm]); u.pm = pm; u.pn = e * NT + pnl + (e >= gap_e ? gap_pn : 0); return true; }
};

#define MFMA32(a, b, c) __builtin_amdgcn_mfma_f32_32x32x16_bf16((a), (b), (c), 0, 0, 0)
#define KR(r) (((r) & 3) + 8 * ((r) >> 2))
constexpr int KSTR = 144, VSTR64 = 192, VSTR128 = 320;
#define NEG_INF (-__builtin_inff())
typedef short v4i16_t __attribute__((ext_vector_type(4)));
DI s16x4 vtr(LAS const unsigned char* p) { return __builtin_bit_cast(s16x4, __builtin_amdgcn_ds_read_tr16_b64_v4i16((LAS v4i16_t*)p)); }
DI bf16x8 packp(const f32x16& p, int s8) { u32x4 w; w.x = pk2(p[s8], p[s8 + 1]); w.y = pk2(p[s8 + 2], p[s8 + 3]); w.z = pk2(p[s8 + 4], p[s8 + 5]); w.w = pk2(p[s8 + 6], p[s8 + 7]); return __builtin_bit_cast(bf16x8, w); }

DI void qk_tile(f32x16& p0, f32x16& p1, LAS const unsigned char* Kt, const bf16x8 (&qf)[4], int r32, int hi) {
    LAS const unsigned char* kb = Kt + r32 * KSTR + hi * 16;
    f32x16 z;
#pragma unroll
    for (int i = 0; i < 16; ++i) z[i] = 0.f;
    p0 = z; p1 = z;
#pragma unroll
    for (int s = 0; s < 4; ++s) {
        const bf16x8 a0 = *(LAS const bf16x8*)(kb + s * 32), a1 = *(LAS const bf16x8*)(kb + 32 * KSTR + s * 32);
        p0 = MFMA32(a0, qf[s], p0); p1 = MFMA32(a1, qf[s], p1); }
}
DI void qk_tile_c(f32x16& p0, f32x16& p1, LAS const unsigned char* Kt, const bf16x8 (&qf)[4], int r32, int hi, const f32x16& cK) {
    LAS const unsigned char* kb = Kt + r32 * KSTR + hi * 16;
    p0 = cK; p1 = cK;
#pragma unroll
    for (int s = 0; s < 4; ++s) {
        const bf16x8 a0 = *(LAS const bf16x8*)(kb + s * 32), a1 = *(LAS const bf16x8*)(kb + 32 * KSTR + s * 32);
        p0 = MFMA32(a0, qf[s], p0); p1 = MFMA32(a1, qf[s], p1); }
}
DI void mask_only(f32x16& p0, f32x16& p1, float dn0, float ksf, float lo, float hi_) {
#pragma unroll
    for (int r = 0; r < 16; ++r) { const float d0 = dn0 + ksf * (float)KR(r), d1 = d0 + 32.0f * ksf;
        p0[r] = (d0 >= lo && d0 <= hi_) ? p0[r] : NEG_INF; p1[r] = (d1 >= lo && d1 <= hi_) ? p1[r] : NEG_INF; }
}
template <int DVB, int VS> DI void pv_tile(f32x16 (&o)[DVB], LAS const unsigned char* Vt, const bf16x8 (&pf)[4], int lane) {
    const int hi = lane >> 5;
    LAS const unsigned char* vb = Vt + (4 * hi + ((lane & 15) >> 2)) * VS + (16 * ((lane >> 4) & 1) + 4 * (lane & 3)) * 2;
#pragma unroll
    for (int db = 0; db < DVB; ++db)
#pragma unroll
        for (int bs = 0; bs < 4; ++bs) {
            const s16x4 lo = vtr(vb + (16 * bs) * VS + db * 64), hh = vtr(vb + (16 * bs + 8) * VS + db * 64);
            const bf16x8 a = __builtin_shufflevector(lo, hh, 0, 1, 2, 3, 4, 5, 6, 7);
            o[db] = MFMA32(a, pf[bs], o[db]); }
}
template <int DVB, int VS> DI void pv_load(bf16x8 (&vf)[DVB][4], LAS const unsigned char* Vt, int lane) {
    const int hi = lane >> 5;
    LAS const unsigned char* vb = Vt + (4 * hi + ((lane & 15) >> 2)) * VS + (16 * ((lane >> 4) & 1) + 4 * (lane & 3)) * 2;
#pragma unroll
    for (int db = 0; db < DVB; ++db)
#pragma unroll
        for (int bs = 0; bs < 4; ++bs) { const s16x4 lo = vtr(vb + (16 * bs) * VS + db * 64), hh = vtr(vb + (16 * bs + 8) * VS + db * 64); vf[db][bs] = __builtin_shufflevector(lo, hh, 0, 1, 2, 3, 4, 5, 6, 7); }
}
template <int DVB> DI void pv_mma(f32x16 (&o)[DVB], const bf16x8 (&vf)[DVB][4], const bf16x8 (&pf)[4]) {
#pragma unroll
    for (int db = 0; db < DVB; ++db)
#pragma unroll
        for (int bs = 0; bs < 4; ++bs) o[db] = MFMA32(vf[db][bs], pf[bs], o[db]);
}
template <bool MASKED> DI void bias_mask(f32x16& p0, f32x16& p1, float slope_s, float dn0, float ksf, float lo, float hi_) {
#pragma unroll
    for (int r = 0; r < 16; ++r) { p0[r] = __builtin_fmaf(slope_s, (float)KR(r), p0[r]); p1[r] = __builtin_fmaf(slope_s, (float)KR(r), p1[r]); }
    if (MASKED) {
#pragma unroll
        for (int r = 0; r < 16; ++r) { const float d0 = dn0 + ksf * (float)KR(r), d1 = d0 + 32.0f * ksf;
            p0[r] = (d0 >= lo && d0 <= hi_) ? p0[r] : NEG_INF; p1[r] = (d1 >= lo && d1 <= hi_) ? p1[r] : NEG_INF; }
    }
}
DI float xmax32(float x) { const auto rr = __builtin_amdgcn_permlane32_swap(__float_as_uint(x), __float_as_uint(x), false, false); return fmaxf(__uint_as_float(rr[0]), __uint_as_float(rr[1])); }
DI float xsum32(float x) { const auto rr = __builtin_amdgcn_permlane32_swap(__float_as_uint(x), __float_as_uint(x), false, false); return __uint_as_float(rr[0]) + __uint_as_float(rr[1]); }
DI u32x4 widen16(const unsigned (&wq)[4]) {
    const auto r0 = __builtin_amdgcn_permlane32_swap(wq[0], wq[1], false, false), r1 = __builtin_amdgcn_permlane32_swap(wq[2], wq[3], false, false);
    const auto s0 = __builtin_amdgcn_permlane32_swap(r0[0], r1[0], false, false), s1 = __builtin_amdgcn_permlane32_swap(r0[1], r1[1], false, false);
    u32x4 ov; ov.x = s0[0]; ov.y = s1[0]; ov.z = s0[1]; ov.w = s1[1]; return ov;
}
DI float wave_minf(float v) { v = fminf(v, dpp_get<0xB1>(v)); v = fminf(v, dpp_get<0x4E>(v)); v = fminf(v, dpp_get<0x141>(v)); v = fminf(v, dpp_get<0x140>(v));
    { const auto rr = __builtin_amdgcn_permlane16_swap(__float_as_uint(v), __float_as_uint(v), false, false); v = fminf(__uint_as_float(rr[0]), __uint_as_float(rr[1])); }
    { const auto rr = __builtin_amdgcn_permlane32_swap(__float_as_uint(v), __float_as_uint(v), false, false); v = fminf(__uint_as_float(rr[0]), __uint_as_float(rr[1])); } return v; }
DI float max16(const f32x16& p) { float a = fmaxf(p[0], p[1]), b = fmaxf(p[2], p[3]);
#pragma unroll
    for (int r = 4; r < 16; r += 2) { a = fmaxf(a, p[r]); b = fmaxf(b, p[r + 1]); } return fmaxf(a, b); }
template <int DVB> DI bool softmax_online(f32x16& p0, f32x16& p1, float base0, float base1, float& m, float& l, f32x16 (&o)[DVB], bf16x8 (&pf)[4]) {
    float mx = fmaxf(max16(p0) + base0, max16(p1) + base1); mx = xmax32(mx);
    const bool grow = __any(mx > m) != 0;
    if (!grow && __all(mx < m - 150.0f)) return false;
    const float mn = fmaxf(m, mx), alpha = __builtin_amdgcn_exp2f(m - mn), e0 = base0 - mn, e1 = base1 - mn;
    float s0 = 0.f, s1 = 0.f;
#pragma unroll
    for (int r = 0; r < 16; ++r) { p0[r] = __builtin_amdgcn_exp2f(p0[r] + e0); p1[r] = __builtin_amdgcn_exp2f(p1[r] + e1); s0 += p0[r]; s1 += p1[r]; }
    float s = s0 + s1; s = xsum32(s);
    l = l * alpha + s; m = mn;
    if (grow) {
#pragma unroll
        for (int db = 0; db < DVB; ++db)
#pragma unroll
            for (int r = 0; r < 16; ++r) o[db][r] *= alpha;
    }
    pf[0] = packp(p0, 0); pf[1] = packp(p0, 8); pf[2] = packp(p1, 0); pf[3] = packp(p1, 8);
    return true;
}
template <int DVB> DI void softmax_pv(f32x16& p0, f32x16& p1, float base0, float base1, float& m, float& l, f32x16 (&o)[DVB], const bf16x8 (&vf)[DVB][4]) {
    float mx = fmaxf(max16(p0) + base0, max16(p1) + base1); mx = xmax32(mx);
    const bool grow = __any(mx > m) != 0;
    if (!grow && __all(mx < m - 56.0f)) return;
    const float mn = fmaxf(m, mx), alpha = __builtin_amdgcn_exp2f(m - mn), e0 = base0 - mn, e1 = base1 - mn;
    if (grow) {
#pragma unroll
        for (int db = 0; db < DVB; ++db)
#pragma unroll
            for (int r = 0; r < 16; ++r) o[db][r] *= alpha;
    }
    float s0 = 0.f, s1 = 0.f;
#pragma unroll
    for (int r = 0; r < 16; ++r) { p0[r] = __builtin_amdgcn_exp2f(p0[r] + e0); s0 += p0[r]; }
    { const bf16x8 pa = packp(p0, 0), pb = packp(p0, 8);
#pragma unroll
      for (int db = 0; db < DVB; ++db) { o[db] = MFMA32(vf[db][0], pa, o[db]); o[db] = MFMA32(vf[db][1], pb, o[db]); } }
#pragma unroll
    for (int r = 0; r < 16; ++r) { p1[r] = __builtin_amdgcn_exp2f(p1[r] + e1); s1 += p1[r]; }
    { const bf16x8 pa = packp(p1, 0), pb = packp(p1, 8);
#pragma unroll
      for (int db = 0; db < DVB; ++db) { o[db] = MFMA32(vf[db][2], pa, o[db]); o[db] = MFMA32(vf[db][3], pb, o[db]); } }
    float s = s0 + s1; s = xsum32(s);
    l = l * alpha + s; m = mn;
}
DI void softmax_stats(const f32x16& p0, const f32x16& p1, float base0, float base1, float& m, float& l) {
    float mx = fmaxf(max16(p0) + base0, max16(p1) + base1); mx = xmax32(mx);
    const float mn = fmaxf(m, mx), alpha = __builtin_amdgcn_exp2f(m - mn), e0 = base0 - mn, e1 = base1 - mn;
    float s0 = 0.f, s1 = 0.f;
#pragma unroll
    for (int r = 0; r < 16; ++r) { s0 += __builtin_amdgcn_exp2f(p0[r] + e0); s1 += __builtin_amdgcn_exp2f(p1[r] + e1); }
    float s = s0 + s1; s = xsum32(s);
    l = l * alpha + s; m = mn;
}
DI void softmax_fixed(f32x16& p0, f32x16& p1, float base0, float base1, float m, bf16x8 (&pf)[4]) {
    const float e0 = base0 - m, e1 = base1 - m;
#pragma unroll
    for (int r = 0; r < 16; ++r) { p0[r] = __builtin_amdgcn_exp2f(p0[r] + e0); p1[r] = __builtin_amdgcn_exp2f(p1[r] + e1); }
    pf[0] = packp(p0, 0); pf[1] = packp(p0, 8); pf[2] = packp(p1, 0); pf[3] = packp(p1, 8);
}

#define STREAM_LOOP2(JFIRST, NEXTJ, LOADA, LOADB, WRITEA, WRITEB, COMPT) do { int j0_ = (JFIRST); if (j0_ >= 0) { int j1_ = NEXTJ(j0_); LOADA(j0_); LOADB((j1_ >= 0 ? j1_ : j0_)); \
    WRITEA(0); __syncthreads(); \
    for (;;) { const int j2_ = (j1_ >= 0) ? NEXTJ(j1_) : -1; LOADA((j2_ >= 0 ? j2_ : j0_)); COMPT(j0_, 0); if (j1_ >= 0) { WRITEB(1); } __syncthreads(); if (j1_ < 0) break; \
               const int j3_ = (j2_ >= 0) ? NEXTJ(j2_) : -1; LOADB((j3_ >= 0 ? j3_ : j1_)); COMPT(j1_, 1); if (j2_ >= 0) { WRITEA(0); } __syncthreads(); if (j2_ < 0) break; j0_ = j2_; j1_ = j3_; } } } while (0)

template <int DVB, int VS, bool MASKED> DI void sm_pv_step(f32x16& p0, f32x16& p1, float slope_s, float dn0, float ksf, float lo, float hi_, float base0, float base1,
                                                            float& m, float& l, f32x16 (&o)[DVB], bf16x8 (&pfo)[4], LAS const unsigned char* Vp, int lane) {
    const int hi = lane >> 5;
    LAS const unsigned char* vb = Vp + (4 * hi + ((lane & 15) >> 2)) * VS + (16 * ((lane >> 4) & 1) + 4 * (lane & 3)) * 2;
#define PVG(bs) { bf16x8 va_[DVB]; _Pragma("unroll") for (int db = 0; db < DVB; ++db) { const s16x4 lo_ = vtr(vb + (16 * (bs)) * VS + db * 64), hh_ = vtr(vb + (16 * (bs) + 8) * VS + db * 64); \
        va_[db] = __builtin_shufflevector(lo_, hh_, 0, 1, 2, 3, 4, 5, 6, 7); } \
        __builtin_amdgcn_sched_group_barrier(0x100, 2 * DVB, 0); \
        _Pragma("unroll") for (int db = 0; db < DVB; ++db) o[db] = MFMA32(va_[db], pfo[bs], o[db]); }
    PVG(0) PVG(1)
    bias_mask<MASKED>(p0, p1, slope_s, dn0, ksf, lo, hi_);
    float mx = fmaxf(max16(p0) + base0, max16(p1) + base1); mx = xmax32(mx);
    const bool grow = __any(mx > m) != 0;
    const float mn = fmaxf(m, mx), alpha = __builtin_amdgcn_exp2f(m - mn), e0 = base0 - mn, e1 = base1 - mn;
    PVG(2)
    float s0 = 0.f, s1 = 0.f;
#pragma unroll
    for (int r = 0; r < 16; ++r) { p0[r] = __builtin_amdgcn_exp2f(p0[r] + e0); s0 += p0[r]; }
    PVG(3)
#pragma unroll
    for (int r = 0; r < 16; ++r) { p1[r] = __builtin_amdgcn_exp2f(p1[r] + e1); s1 += p1[r]; }
#undef PVG
    float s = s0 + s1; s = xsum32(s);
    l = l * alpha + s; m = mn;
    if (grow) {
#pragma unroll
        for (int db = 0; db < DVB; ++db)
#pragma unroll
            for (int r = 0; r < 16; ++r) o[db][r] *= alpha;
    }
    pfo[0] = packp(p0, 0); pfo[1] = packp(p0, 8); pfo[2] = packp(p1, 0); pfo[3] = packp(p1, 8);
}
#define STREAM_LOOP3(JFIRST, NEXTJ, LOADA, LOADB, WRITEA, WRITEB, STEPT, FINALT) do { int j0_ = (JFIRST); if (j0_ >= 0) { int j1_ = NEXTJ(j0_); LOADA(j0_); LOADB((j1_ >= 0 ? j1_ : j0_)); \
    WRITEA(0); __syncthreads(); int bc_ = 0, bp_ = 0; \
    for (;;) { const int j2_ = (j1_ >= 0) ? NEXTJ(j1_) : -1; LOADA((j2_ >= 0 ? j2_ : j0_)); STEPT(j0_, bc_, bp_); { const int bn_ = bc_ == 2 ? 0 : bc_ + 1; if (j1_ >= 0) { WRITEB(bn_); } __syncthreads(); bp_ = bc_; if (j1_ < 0) break; bc_ = bn_; } \
               const int j3_ = (j2_ >= 0) ? NEXTJ(j2_) : -1; LOADB((j3_ >= 0 ? j3_ : j1_)); STEPT(j1_, bc_, bp_); { const int bn_ = bc_ == 2 ? 0 : bc_ + 1; if (j2_ >= 0) { WRITEA(bn_); } __syncthreads(); bp_ = bc_; if (j2_ < 0) break; bc_ = bn_; } j0_ = j2_; j1_ = j3_; } \
    FINALT(bp_); __syncthreads(); } } while (0)

struct DiffArgs { const bf16* proj; bf16* odiff; const float* subln; const float* lam; const int* kn2; };
constexpr int DIFF_STG = 2 * 64 * KSTR + 64 * VSTR128;
DI void diff_unit(const DiffArgs& A, int b, int h, int qb, LAS unsigned char* lds, int tid) {
    asm volatile("" : "+v"(tid));
    const int lane = tid & 63, w = __builtin_amdgcn_readfirstlane(tid >> 6), r32 = lane & 31, hi = lane >> 5;
    const int comp = w >> 2, qs = w & 3, q0w = qb * 128 + qs * 32, tq = q0w + r32;
    const size_t rowbase = (size_t)b * SEQ;
    const float slope2 = __builtin_amdgcn_exp2f(-(float)(h + 1)) * LOG2E;
    bf16x8 qf[4];
    { const bf16* qp = A.proj + (rowbase + tq) * PN + DQ_OFF + h * 128 + comp * 64 + hi * 8;
#pragma unroll
      for (int s = 0; s < 4; ++s) qf[s] = *(const bf16x8*)(qp + 16 * s); }
    f32x16 o[4];
#pragma unroll
    for (int d = 0; d < 4; ++d)
#pragma unroll
        for (int r = 0; r < 16; ++r) o[d][r] = 0.f;
    float m = -1e30f, l = 0.f;
    const int NT = 2 * qb + 2;
    int tmin = 0; float sbw = 0.f;
    LAS float* sbx2 = (LAS float*)(lds + 3 * DIFF_STG) + 8;
    { float q2 = 0.f;
#pragma unroll
      for (int s = 0; s < 4; ++s) { const u32x4 qw = __builtin_bit_cast(u32x4, qf[s]);
#pragma unroll
          for (int i = 0; i < 4; ++i) { const float a = bflo(qw[i]), c2 = bfhi(qw[i]); q2 += a * a + c2 * c2; } }
      q2 = sw32_sum(q2);
      q2 = row16_max(sw16_max(q2));
      const float k2 = __builtin_bit_cast(float, A.kn2[(b * 16 + h * 2 + comp) * 2]) + __builtin_bit_cast(float, A.kn2[(b * 16 + h * 2 + comp) * 2 + 1]);
      float sb = sqrtf(q2 * k2) * 1.02f;
      LAS float* sbx = (LAS float*)(lds + 3 * DIFF_STG);
      if (lane == 0) sbx[w] = sb;
      __syncthreads();
#pragma unroll
      for (int i = 0; i < 8; ++i) sb = fmaxf(sb, sbx[i]);
      sbw = sb;
      const float x = (float)(qb * 128) - (59.0f + 2.0f * sb) / slope2 - 63.0f;
      tmin = x > 0.f ? ((int)x) >> 6 : 0; if (tmin > NT - 1) tmin = NT - 1; }
    const char* kgb = (const char*)(A.proj + rowbase * PN + DK_OFF + h * 128); const char* vgb = (const char*)(A.proj + rowbase * PN + DV_OFF + h * 128);
    const unsigned kgo = (unsigned)(((tid >> 3) * PN + (tid & 7) * 8) * 2), vgo = (unsigned)(((tid >> 4) * PN + (tid & 15) * 8) * 2);
    const int kdst = (tid >> 3) * KSTR + (tid & 7) * 16, vdst = 2 * 64 * KSTR + (tid >> 4) * VSTR128 + (tid & 15) * 16;
    u32x4 ak0, ak1, av0, av1, bk0, bk1, bv0, bv1;
#define D_LOADX(t, K0, K1, V0, V1) do { const char* kt_ = kgb + (size_t)(t) * 64 * PN * 2; const char* vt_ = vgb + (size_t)(t) * 64 * PN * 2; K0 = *(const u32x4*)(kt_ + kgo); K1 = *(const u32x4*)(kt_ + 128 + kgo); V0 = *(const u32x4*)(vt_ + vgo); V1 = *(const u32x4*)(vt_ + (size_t)32 * PN * 2 + vgo); } while (0)
#define D_LOADA(t) D_LOADX(t, ak0, ak1, av0, av1)
#define D_LOADB(t) D_LOADX(t, bk0, bk1, bv0, bv1)
#define D_WRITEX(bf, K0, K1, V0, V1) do { LAS unsigned char* b_ = lds + (bf) * DIFF_STG; *(LAS u32x4*)(b_ + kdst) = K0; *(LAS u32x4*)(b_ + 64 * KSTR + kdst) = K1; *(LAS u32x4*)(b_ + vdst) = V0; *(LAS u32x4*)(b_ + vdst + 32 * VSTR128) = V1; } while (0)
#define D_WRITEA(bf) D_WRITEX(bf, ak0, ak1, av0, av1)
#define D_WRITEB(bf) D_WRITEX(bf, bk0, bk1, bv0, bv1)
#define D_NEXT(t) (((t) - 1 >= tmin) ? (t) - 1 : -1)
#define D_STEP(t, bc, bp) do { const int k0_ = (t) * 64; LAS const unsigned char* b_ = lds + (bc) * DIFF_STG; LAS const unsigned char* vp_ = lds + (bp) * DIFF_STG + 2 * 64 * KSTR; f32x16 p0, p1; \
        qk_tile(p0, p1, b_ + comp * 64 * KSTR, qf, r32, hi); const float dn0_ = (float)(k0_ - tq + 4 * hi); \
        if (k0_ + 63 > q0w) sm_pv_step<4, VSTR128, true>(p0, p1, slope2, dn0_, 1.0f, NEG_INF, 0.0f, slope2 * dn0_, slope2 * (dn0_ + 32.0f), m, l, o, pfo, vp_, lane); \
        else sm_pv_step<4, VSTR128, false>(p0, p1, slope2, dn0_, 1.0f, NEG_INF, 0.0f, slope2 * dn0_, slope2 * (dn0_ + 32.0f), m, l, o, pfo, vp_, lane); \
          \
          \
        if ((t) == NT - 3) { const float mm_ = wave_minf(m); if (lane == 0) sbx2[w] = (float)q0w - (57.0f + sbw - mm_) / slope2 - 63.0f; } \
        if ((t) == NT - 4) { float xm_ = sbx2[0]; _Pragma("unroll") for (int i_ = 1; i_ < 8; ++i_) xm_ = fminf(xm_, sbx2[i_]); const int tn_ = xm_ > 0.f ? ((int)xm_) >> 6 : 0; if (tn_ > tmin) tmin = tn_; } } while (0)
#define D_FINAL(bp) do { pv_tile<4, VSTR128>(o, lds + (bp) * DIFF_STG + 2 * 64 * KSTR, pfo, lane); } while (0)
    bf16x8 pfo[4];
#pragma unroll
    for (int i = 0; i < 4; ++i) pfo[i] = (bf16x8){0, 0, 0, 0, 0, 0, 0, 0};
    STREAM_LOOP3(NT - 1, D_NEXT, D_LOADA, D_LOADB, D_WRITEA, D_WRITEB, D_STEP, D_FINAL);
#undef D_LOADX
#undef D_LOADA
#undef D_LOADB
#undef D_WRITEX
#undef D_WRITEA
#undef D_WRITEB
#undef D_NEXT
#undef D_STEP
#undef D_FINAL
    const float inv_l = 1.0f / l;
    LAS float* xch = (LAS float*)lds;
    if (comp == 1) {
#pragma unroll
        for (int d = 0; d < 4; ++d)
#pragma unroll
            for (int r = 0; r < 16; ++r) xch[((qs * 4 + d) * 16 + r) * 64 + lane] = o[d][r] * inv_l;
    }
    __syncthreads();
    if (comp == 0) {
        const float lam = A.lam[0]; float ss = 0.f;
#pragma unroll
        for (int d = 0; d < 4; ++d)
#pragma unroll
            for (int r = 0; r < 16; ++r) { const float v = o[d][r] * inv_l - lam * xch[((qs * 4 + d) * 16 + r) * 64 + lane]; o[d][r] = v; ss += v * v; }
        ss = sw32_sum(ss);
        const float rs = __builtin_amdgcn_rsqf(ss * (1.0f / 128.0f) + LN_EPS) * ((1.0f - LAMBDA_INIT) * ODSCALE);
        unsigned char* op = (unsigned char*)A.odiff + (rowbase + tq) * (2 * DM) + h * 128 + 16 * hi;
#pragma unroll
        for (int d = 0; d < 4; ++d) { unsigned wq[4];
#pragma unroll
            for (int gr = 0; gr < 4; ++gr) { const int d0 = 32 * d + 8 * gr; const f32x4 g4 = *(const f32x4*)(A.subln + d0 + 4 * hi);
                wq[gr] = pack4_fp8(o[d][4 * gr] * rs * g4[0], o[d][4 * gr + 1] * rs * g4[1], o[d][4 * gr + 2] * rs * g4[2], o[d][4 * gr + 3] * rs * g4[3]); }
            *(u32x4*)(op + 32 * d) = widen16(wq); }
    }
    __syncthreads();
}

struct NsaArgs { const bf16* proj; const bf16* kcmp; bf16* onsa; };
constexpr int NSA_STG = 64 * KSTR + 64 * VSTR64;
constexpr int NSA_IMPA = 2 * NSA_STG, NSA_IMPB = NSA_IMPA + 8 * 8 * 64 * 4, NSA_SEL = NSA_IMPB + 8 * 8 * 64 * 4, NSA_WOR = NSA_SEL + 64 * 8, NSA_RES = NSA_WOR + 8 * 8, NSA_LDS = NSA_RES + 8 * 8192;
DI void nsa_unit(const NsaArgs& A, int b, int g, int qb, LAS unsigned char* lds, int tid) {
    asm volatile("" : "+v"(tid));
    const int lane = tid & 63, w = __builtin_amdgcn_readfirstlane(tid >> 6), c = lane & 31, hi = lane >> 5;
    const int ql = c >> 2, hd = c & 3, head = 4 * g + hd, tq = 64 * qb + 8 * w + ql;
    const size_t rowbase = (size_t)b * SEQ, row = rowbase + tq;
    const float slope2 = __builtin_amdgcn_exp2f(-0.5f * (float)(head + 1)) * LOG2E;
    bf16x8 qf[4];
    { const bf16* qp = A.proj + row * PN + NQ_OFF + head * 64 + hi * 8;
#pragma unroll
      for (int s = 0; s < 4; ++s) qf[s] = *(const bf16x8*)(qp + 16 * s); }
    float gt0, gt1, gt2;
    { const bf16* gp = A.proj + row * PN + NG_OFF + head * 3; gt0 = bf2f(gp[0]); gt1 = bf2f(gp[1]); gt2 = bf2f(gp[2]); }
    f32x16 o[2];
#pragma unroll
    for (int d = 0; d < 2; ++d)
#pragma unroll
        for (int r = 0; r < 16; ++r) o[d][r] = 0.f;
    LAS float* resl = (LAS float*)(lds + NSA_RES) + w * 2048 + lane;
    LAS float* impA = (LAS float*)(lds + NSA_IMPA) + w * 512;
    LAS float* impB = (LAS float*)(lds + NSA_IMPB) + w * 512;
    LAS unsigned long long* selm = (LAS unsigned long long*)(lds + NSA_SEL);
    LAS unsigned long long* worm = (LAS unsigned long long*)(lds + NSA_WOR);
#pragma unroll
    for (int i = 0; i < 8; ++i) { impA[i * 64 + lane] = 0.f; impB[i * 64 + lane] = 0.f; }
    const int krow = tid >> 3, kch = tid & 7, kdst = krow * KSTR + kch * 16, vdst = 64 * KSTR + krow * VSTR64 + kch * 16;
    u32x4 ska, sva, skb, svb;
#define N_WRITEA(bf) do { LAS unsigned char* b_ = lds + (bf) * NSA_STG; *(LAS u32x4*)(b_ + kdst) = ska; *(LAS u32x4*)(b_ + vdst) = sva; } while (0)
#define N_WRITEB(bf) do { LAS unsigned char* b_ = lds + (bf) * NSA_STG; *(LAS u32x4*)(b_ + kdst) = skb; *(LAS u32x4*)(b_ + vdst) = svb; } while (0)
    const int ntc = (4 * qb + 3 + 63) >> 6;
    const char* kcb = (const char*)(A.kcmp + (size_t)(b * 4 + g) * 256 * 256);
    const unsigned cgo = (unsigned)((krow * 256 + kch * 8) * 2), pgo = (unsigned)((krow * PN + kch * 8) * 2);
    float m1 = -1e30f, l1 = 0.f;
#define C_NEXT(t) ((t) - 1)
#define C_LOADX(t, SK, SV) do { SK = *(const u32x4*)(kcb + (size_t)(t) * 64 * 256 * 2 + cgo); SV = *(const u32x4*)(kcb + (size_t)8192 * 256 * 2 + (size_t)(t) * 64 * 256 * 2 + cgo); } while (0)
#define C_LOADA(t) C_LOADX(t, ska, sva)
#define C_LOADB(t) C_LOADX(t, skb, svb)
#define C_DN0(t) ((float)(1024 * (t) + 31 - tq + 64 * hi))
#define C_COMP1(t, bf) do { f32x16 p0, p1; qk_tile(p0, p1, lds + (bf) * NSA_STG, qf, c, hi); const float dn0_ = C_DN0(t); \
        bias_mask<true>(p0, p1, slope2 * 16.0f, dn0_, 16.0f, NEG_INF, 0.0f); softmax_stats(p0, p1, slope2 * dn0_, slope2 * (dn0_ + 512.0f), m1, l1); } while (0)
    STREAM_LOOP2(ntc - 1, C_NEXT, C_LOADA, C_LOADB, N_WRITEA, N_WRITEB, C_COMP1);
    const float il1 = l1 > 0.f ? 1.0f / l1 : 0.f;
#define C_COMP2(t, bf) do { f32x16 p0, p1; bf16x8 pf[4]; LAS const unsigned char* b_ = lds + (bf) * NSA_STG; qk_tile(p0, p1, b_, qf, c, hi); const float dn0_ = C_DN0(t); \
        bias_mask<true>(p0, p1, slope2 * 16.0f, dn0_, 16.0f, NEG_INF, 0.0f); softmax_fixed(p0, p1, slope2 * dn0_, slope2 * (dn0_ + 512.0f), m1, pf); \
        pv_tile<2, VSTR64>(o, b_ + 64 * KSTR, pf, lane); \
        _Pragma("unroll") for (int bb = 0; bb < 2; ++bb) _Pragma("unroll") for (int gr = 0; gr < 4; ++gr) { \
            const float x0 = (bb ? p1[4 * gr] : p0[4 * gr]) * il1, x1 = (bb ? p1[4 * gr + 1] : p0[4 * gr + 1]) * il1, x2 = (bb ? p1[4 * gr + 2] : p0[4 * gr + 2]) * il1, x3 = (bb ? p1[4 * gr + 3] : p0[4 * gr + 3]) * il1; \
            float av = ((x0 + x1) + x2) + 0.5f * x3, bv = 0.5f * x3; av += dpp_get<0xB1>(av); bv += dpp_get<0xB1>(bv); av += dpp_get<0x4E>(av); bv += dpp_get<0x4E>(bv); \
            const int j2_ = 16 * (t) + 8 * bb + 2 * gr + hi; if (hd == 0) { impA[ql * 64 + j2_] = av; if (j2_ + 1 < 64) impB[ql * 64 + j2_ + 1] = bv; } } } while (0)
    STREAM_LOOP2(ntc - 1, C_NEXT, C_LOADA, C_LOADB, N_WRITEA, N_WRITEB, C_COMP2);
#pragma unroll
    for (int d = 0; d < 2; ++d)
#pragma unroll
        for (int r = 0; r < 16; ++r) { resl[(d * 16 + r) * 64] = o[d][r] * (gt0 * il1); o[d][r] = 0.f; }
    const int cur = qb;
    unsigned long long wor = 0ull, wand = ~0ull;
    if (cur < 16) {
        const unsigned long long mk = __ballot(lane <= cur);
        if (lane < 8) selm[w * 8 + lane] = mk;
        wor = mk; wand = mk;
    } else {
        unsigned key[8], thr[8];
#pragma unroll
        for (int qi = 0; qi < 8; ++qi) { float v = impA[qi * 64 + lane] + impB[qi * 64 + lane];
            if (lane == 0 || lane == cur || lane == cur - 1) v = 1e30f;
            key[qi] = lane <= cur ? __builtin_bit_cast(unsigned, v) + 1u : 0u; thr[qi] = 0u; }
        for (int bit = 31; bit >= 0; --bit) {
#pragma unroll
            for (int qi = 0; qi < 8; ++qi) { const unsigned cand = thr[qi] | (1u << bit); if (__popcll(__ballot(key[qi] >= cand)) >= 16) thr[qi] = cand; }
        }
#pragma unroll
        for (int qi = 0; qi < 8; ++qi) {
            const unsigned long long gt = __ballot(key[qi] > thr[qi]), eq = __ballot(key[qi] == thr[qi]);
            const int need = 16 - __popcll(gt);
            const int below = (int)__builtin_amdgcn_mbcnt_hi((unsigned)(eq >> 32), __builtin_amdgcn_mbcnt_lo((unsigned)eq, 0u));
            const unsigned long long mk = gt | __ballot(key[qi] == thr[qi] && below < need);
            if (lane == 0) selm[w * 8 + qi] = mk;
            wor |= mk; wand &= mk;
        }
    }
    if (lane == 0) worm[w] = wor;
    __syncthreads();
    unsigned long long bmask = 0ull;
#pragma unroll
    for (int i = 0; i < 8; ++i) bmask |= worm[i];
    const unsigned long long mym = selm[w * 8 + ql];
    const char* pgb = (const char*)(A.proj + rowbase * PN + g * 64);
    f32x16 cK;
#pragma unroll
    for (int r = 0; r < 16; ++r) cK[r] = slope2 * (float)KR(r);
    float m = -1e30f, l = 0.f;
#define S_FIRST (63 - (int)__builtin_clzll(bmask))
#define S_NEXT(j) (((bmask & ((1ull << (j)) - 1ull)) == 0ull) ? -1 : 63 - (int)__builtin_clzll(bmask & ((1ull << (j)) - 1ull)))
#define S_LOADX(j, SK, SV) do { const char* t_ = pgb + (size_t)(j) * 64 * PN * 2; SK = *(const u32x4*)(t_ + KS_OFF * 2 + pgo); SV = *(const u32x4*)(t_ + VS_OFF * 2 + pgo); } while (0)
#define S_LOADA(j) S_LOADX(j, ska, sva)
#define S_LOADB(j) S_LOADX(j, skb, svb)
#define S_COMP(j, bf) do { if ((wor >> (j)) & 1ull) { f32x16 p0, p1; bf16x8 pf[4]; LAS const unsigned char* b_ = lds + (bf) * NSA_STG; qk_tile_c(p0, p1, b_, qf, c, hi, cK); \
        const float dn0_ = (float)(64 * (j) - tq + 4 * hi); const float selb_ = ((mym >> (j)) & 1ull) ? 0.0f : NEG_INF;        \
        if ((j) == cur) mask_only(p0, p1, dn0_, 1.0f, NEG_INF, 0.0f);        \
        bf16x8 vf_[2][4]; pv_load<2, VSTR64>(vf_, b_ + 64 * KSTR, lane); \
        softmax_pv<2>(p0, p1, slope2 * dn0_ + selb_, slope2 * (dn0_ + 32.0f) + selb_, m, l, o, vf_); } } while (0)
    STREAM_LOOP2(S_FIRST, S_NEXT, S_LOADA, S_LOADB, N_WRITEA, N_WRITEB, S_COMP);
    { const float sc = gt1 / l;
#pragma unroll
      for (int d = 0; d < 2; ++d)
#pragma unroll
          for (int r = 0; r < 16; ++r) { resl[(d * 16 + r) * 64] += o[d][r] * sc; o[d][r] = 0.f; } }
    m = -1e30f; l = 0.f;
    const int wfirst = qb >= 8 ? qb - 8 : 0;
#define W_NEXT(j) (((j) - 1 >= wfirst) ? (j) - 1 : -1)
#define W_LOADX(j, SK, SV) do { const char* t_ = pgb + (size_t)(j) * 64 * PN * 2; SK = *(const u32x4*)(t_ + KW_OFF * 2 + pgo); SV = *(const u32x4*)(t_ + VW_OFF * 2 + pgo); } while (0)
#define W_LOADA(j) W_LOADX(j, ska, sva)
#define W_LOADB(j) W_LOADX(j, skb, svb)
#define W_COMP(j, bf) do { f32x16 p0, p1; bf16x8 pf[4]; LAS const unsigned char* b_ = lds + (bf) * NSA_STG; qk_tile_c(p0, p1, b_, qf, c, hi, cK); \
        const float dn0_ = (float)(64 * (j) - tq + 4 * hi); \
        if ((j) == qb || (j) == qb - 8) mask_only(p0, p1, dn0_, 1.0f, -511.0f, 0.0f); \
        bf16x8 vf_[2][4]; pv_load<2, VSTR64>(vf_, b_ + 64 * KSTR, lane); \
        softmax_pv<2>(p0, p1, slope2 * dn0_, slope2 * (dn0_ + 32.0f), m, l, o, vf_); } while (0)
    STREAM_LOOP2(qb, W_NEXT, W_LOADA, W_LOADB, N_WRITEA, N_WRITEB, W_COMP);
    { const float sc = gt2 / l;
      unsigned char* op = (unsigned char*)A.onsa + row * (2 * DM) + DM + head * 64 + 16 * hi;
#pragma unroll
      for (int d = 0; d < 2; ++d) { unsigned wq[4];
#pragma unroll
          for (int gr = 0; gr < 4; ++gr)
              wq[gr] = pack4_fp8((resl[(d * 16 + 4 * gr) * 64] + o[d][4 * gr] * sc) * ONSCALE, (resl[(d * 16 + 4 * gr + 1) * 64] + o[d][4 * gr + 1] * sc) * ONSCALE,
                                 (resl[(d * 16 + 4 * gr + 2) * 64] + o[d][4 * gr + 2] * sc) * ONSCALE, (resl[(d * 16 + 4 * gr + 3) * 64] + o[d][4 * gr + 3] * sc) * ONSCALE);
          *(u32x4*)(op + 32 * d) = widen16(wq); } }
#undef N_WRITEA
#undef N_WRITEB
#undef C_NEXT
#undef C_LOADX
#undef C_LOADA
#undef C_LOADB
#undef C_DN0
#undef C_COMP1
#undef C_COMP2
#undef S_FIRST
#undef S_NEXT
#undef S_LOADX
#undef S_LOADA
#undef S_LOADB
#undef S_COMP
#undef W_NEXT
#undef W_LOADX
#undef W_LOADA
#undef W_LOADB
#undef W_COMP
}

constexpr size_t MiB = 1u << 20;
constexpr size_t WS_PROJ = 0;
constexpr size_t WS_XB = 496 * MiB;
constexpr size_t WS_ODIFF = 496 * MiB;
constexpr size_t WS_ONSA = 560 * MiB;
constexpr size_t WS_XQ = 560 * MiB;
constexpr size_t WS_WIN = 624 * MiB;
constexpr size_t WS_BLK = 640 * MiB;
constexpr size_t WS_HID = 704 * MiB;
constexpr size_t WS_CMP = 712 * MiB;
constexpr size_t WS_MIXED = 720 * MiB;
constexpr size_t WS_T1 = 784 * MiB;
constexpr size_t WS_HPRE = 0;
constexpr size_t WS_WE2A = 848 * MiB;
constexpr size_t WS_WE2B = 912 * MiB;
constexpr int WE2_SPLIT = 24, WE2_GAP_PN = (int)((WS_WE2B - (WS_WE2A + (size_t)WE2_SPLIT * 2 * MiB)) / (512 * 1024));
constexpr size_t WS_B1H = 784 * MiB;
constexpr size_t WS_B2H = 785 * MiB;
constexpr size_t WS_HB = 192 * MiB;
constexpr size_t WS_HQ = 128 * MiB;
constexpr size_t WS_XG = 256 * MiB;
constexpr size_t WS_ACT = 528 * MiB;
constexpr size_t WS_SMALLW = 896 * MiB;
constexpr size_t WS_PHI1 = WS_SMALLW;
constexpr size_t WS_PHI2 = WS_SMALLW + 2 * MiB;
constexpr size_t WS_WBRD = WS_SMALLW + 3 * MiB;
constexpr size_t WS_WBRN = WS_SMALLW + 5 * MiB;
constexpr size_t WS_WO = WS_SMALLW + 7 * MiB;
constexpr size_t WS_WPG = WS_SMALLW + 9 * MiB;
constexpr size_t WS_WPP = WS_SMALLW + 11 * MiB;
constexpr size_t WS_BIASIN = WS_SMALLW + 12 * MiB;
constexpr size_t WS_LAM = WS_SMALLW + 13 * MiB;
constexpr size_t WS_WMGQ = 788 * MiB;
constexpr size_t WS_PB = 912 * MiB;
constexpr size_t WS_PLE = 928 * MiB;
constexpr size_t WS_ROUTE = 992 * MiB;
constexpr size_t WS_TOPE = WS_ROUTE;
constexpr size_t WS_GATE = WS_ROUTE + 1 * MiB;
constexpr size_t WS_POS = WS_ROUTE + 2 * MiB;
constexpr size_t WS_SLOTOF = WS_ROUTE + 3 * MiB;
constexpr size_t WS_SLOTGATE = WS_ROUTE + 4 * MiB;
constexpr size_t WS_BLKE = WS_ROUTE + 5 * MiB;
constexpr size_t WS_SLOTTOK = WS_ROUTE + 6 * MiB;
constexpr size_t WS_CTL = 1000 * MiB;
constexpr size_t CTL_BYTES = 65536;
constexpr size_t WS_NEED = 1001 * MiB;

constexpr int LDS_BYTES = 147456;
constexpr int LDS_ITEM = LDS_BYTES - 64;

struct Args {
    const float* in[32]; float* out; unsigned char* ws; int ph_lo, ph_hi;
};

DI int lane_id() { int l; asm volatile("v_mbcnt_lo_u32_b32 %0, -1, 0\n\tv_mbcnt_hi_u32_b32 %0, -1, %0" : "=v"(l)); return l; }
DI float wave_sum(float v) { return sw32_sum(sw16_sum(row16_sum(v))); }
DI void convert_rows(const float* src, bf16* dst, size_t n8, size_t gtid, size_t nthr) {
    size_t i = gtid;
    for (; i + 3 * nthr < n8; i += 4 * nthr) {
        f32x4 a[4], b[4];
#pragma unroll
        for (int u = 0; u < 4; ++u) { a[u] = __builtin_nontemporal_load((const f32x4*)(src + 8 * (i + u * nthr))); b[u] = __builtin_nontemporal_load((const f32x4*)(src + 8 * (i + u * nthr) + 4)); }
#pragma unroll
        for (int u = 0; u < 4; ++u) *(u32x4*)(dst + 8 * (i + u * nthr)) = pack8(a[u], b[u]);
    }
    for (; i < n8; i += nthr) { const f32x4 a = *(const f32x4*)(src + 8 * i), b = *(const f32x4*)(src + 8 * i + 4); *(u32x4*)(dst + 8 * i) = pack8(a, b); }
}
DI void convert_rows_2(const float* src, bf16* dst, unsigned char* dst8, size_t n8, size_t gtid, size_t nthr) {
    size_t i = gtid;
    for (; i + 3 * nthr < n8; i += 4 * nthr) {
        f32x4 a[4], b[4];
#pragma unroll
        for (int u = 0; u < 4; ++u) { a[u] = __builtin_nontemporal_load((const f32x4*)(src + 8 * (i + u * nthr))); b[u] = __builtin_nontemporal_load((const f32x4*)(src + 8 * (i + u * nthr) + 4)); }
#pragma unroll
        for (int u = 0; u < 4; ++u) { *(u32x4*)(dst + 8 * (i + u * nthr)) = pack8(a[u], b[u]);
            u32x2 o8; o8.x = pack4_fp8(a[u][0], a[u][1], a[u][2], a[u][3]); o8.y = pack4_fp8(b[u][0], b[u][1], b[u][2], b[u][3]); *(u32x2*)(dst8 + 8 * (i + u * nthr)) = o8; }
    }
    for (; i < n8; i += nthr) { const f32x4 a = *(const f32x4*)(src + 8 * i), b = *(const f32x4*)(src + 8 * i + 4); *(u32x4*)(dst + 8 * i) = pack8(a, b);
        u32x2 o8; o8.x = pack4_fp8(a[0], a[1], a[2], a[3]); o8.y = pack4_fp8(b[0], b[1], b[2], b[3]); *(u32x2*)(dst8 + 8 * i) = o8; }
}
template <int MODE> DI void transpose_item(const float* W, int K, int N, bf16* WT, int row_off, LAS float* scr, int item, int lane, bool f8 = false, int ldk8 = 0, int nload = -1, int nstore = -1) {
    const int nblk = (N + 31) >> 5, kb = item / nblk, nb = item - kb * nblk, k0 = 64 * kb, n0 = 32 * nb;
    const int nn = n0 + (lane & 31); const int NL = nload < 0 ? N : nload, NS = nstore < 0 ? N : nstore;
#pragma unroll 8
    for (int i = 0; i < 32; ++i) { const int kk = 2 * i + (lane >> 5); scr[kk * 33 + (lane & 31)] = nn < NL ? __builtin_nontemporal_load(W + (size_t)(k0 + kk) * N + nn) : 0.f; }
    asm volatile("s_waitcnt lgkmcnt(0)" ::: "memory");
    const int cc = lane & 7;
#pragma unroll
    for (int j = 0; j < 4; ++j) { const int nl = (lane >> 3) + 8 * j, n = n0 + nl; const LAS float* s = scr + (8 * cc) * 33 + nl;
        u32x4 ov; ov.x = pk2(s[0], s[33]); ov.y = pk2(s[2 * 33], s[3 * 33]); ov.z = pk2(s[4 * 33], s[5 * 33]); ov.w = pk2(s[6 * 33], s[7 * 33]);
        int dr; if (MODE == 1) { const int bj = n >> 10, c2 = n & 1023; dr = (c2 >> 7) * 256 + bj * 128 + (c2 & 127); } else dr = row_off + n;
        if (f8) { u32x2 o8; o8.x = pack4_fp8(s[0] * W1SCALE, s[33] * W1SCALE, s[2 * 33] * W1SCALE, s[3 * 33] * W1SCALE); o8.y = pack4_fp8(s[4 * 33] * W1SCALE, s[5 * 33] * W1SCALE, s[6 * 33] * W1SCALE, s[7 * 33] * W1SCALE);
            if (n < NS) *(u32x2*)((unsigned char*)WT + (size_t)dr * (ldk8 ? ldk8 : K) + k0 + 8 * cc) = o8; }
        else if (n < NS) *(u32x4*)(WT + (size_t)dr * K + k0 + 8 * cc) = ov; }
    asm volatile("s_waitcnt lgkmcnt(0)" ::: "memory");
}
template <int MODE, bool F8 = false> DI void transpose_big64(const float* W, int K, int N, bf16* WT, LAS float* scr, int item, int lane, float sc = 1.0f) {
    const int nblk = N >> 6, kb = item / nblk, nb = item - kb * nblk, k0 = 64 * kb, n0 = 64 * nb;
    { const int c4 = (lane & 15) * 4, r0 = lane >> 4;
#pragma unroll 4
      for (int i = 0; i < 16; ++i) { const int kk = 4 * i + r0; const f32x4 v = __builtin_nontemporal_load((const f32x4*)(W + (size_t)(k0 + kk) * N + n0 + c4));
          *(LAS f32x4*)(scr + kk * 68 + ((c4 + 4 * (kk >> 3)) & 63)) = v; } }
    asm volatile("s_waitcnt lgkmcnt(0)" ::: "memory");
    const int kc = lane & 7;
#pragma unroll
    for (int j = 0; j < 8; ++j) { const int nl = (lane >> 3) + 8 * j, n = n0 + nl; const LAS float* s = scr + (8 * kc) * 68 + ((nl + 4 * kc) & 63);
        u32x4 ov; ov.x = pk2(s[0], s[68]); ov.y = pk2(s[2 * 68], s[3 * 68]); ov.z = pk2(s[4 * 68], s[5 * 68]); ov.w = pk2(s[6 * 68], s[7 * 68]);
        int dr; if (MODE == 1) { const int bj = n >> 10, c2 = n & 1023; dr = (c2 >> 7) * 256 + bj * 128 + (c2 & 127); } else dr = n;
        if constexpr (F8) { u32x2 o8; o8.x = pack4_fp8(s[0] * sc, s[68] * sc, s[2 * 68] * sc, s[3 * 68] * sc); o8.y = pack4_fp8(s[4 * 68] * sc, s[5 * 68] * sc, s[6 * 68] * sc, s[7 * 68] * sc);
            *(u32x2*)((unsigned char*)WT + (size_t)dr * K + k0 + 8 * kc) = o8; }
        else *(u32x4*)(WT + (size_t)dr * K + k0 + 8 * kc) = ov; }
    asm volatile("s_waitcnt lgkmcnt(0)" ::: "memory");
}
struct TrJob { const float* W; int K, N; bf16* WT; int row_off; };

#define RLX_AGENT __ATOMIC_RELAXED, __HIP_MEMORY_SCOPE_AGENT
#define XB_TMO      128
#define XB_XCNT(j)  (256  + 64 * (j))
#define XB_XSUB(j)  (1280 + 64 * (j))
#define XB_XGEN(j)  (2304 + 64 * (j))
#define XB_TOP      3328
#define XB_TOPGEN   3392
#define XCD_BAR_WORDS 3456
#define XB_SPIN_CAP (1u << 18)

__device__ __forceinline__ unsigned xb_ld(unsigned* p)              { return __hip_atomic_load(p, __ATOMIC_RELAXED, __HIP_MEMORY_SCOPE_AGENT); }
__device__ __forceinline__ unsigned xb_add(unsigned* p, unsigned v) { return __hip_atomic_fetch_add(p, v, __ATOMIC_RELAXED, __HIP_MEMORY_SCOPE_AGENT); }
__device__ __forceinline__ unsigned xb_xcc_id() { return (unsigned)__builtin_amdgcn_s_getreg((3 << 11) | 20) & 0xFu; }
#define XB_SPIN(cond, bar) do { unsigned _sp = 0; while (cond) { __builtin_amdgcn_s_sleep(1); \
    if ((++_sp & 255u) == 0u) { if (xb_ld(&(bar)[XB_TMO])) break; if (_sp > XB_SPIN_CAP) { atomicAdd(&(bar)[XB_TMO], 1u); break; } } } } while (0)

struct XcdBarrier {
    unsigned* bar; unsigned x;
    volatile LAS unsigned* st;
};

__device__ __forceinline__ XcdBarrier xcd_barrier_post(unsigned* bar, volatile LAS unsigned* st, const int tid) {
    XcdBarrier b; b.bar = bar; b.x = xb_xcc_id(); b.st = st;
    if (tid == 0) (void)xb_add(&bar[XB_XCNT(b.x)], 1u);
    return b;
}
__device__ __forceinline__ void xcd_barrier_complete(unsigned* bar, unsigned x, unsigned& nloc, unsigned& nx) {
    const unsigned G = gridDim.x * gridDim.y * gridDim.z;
    unsigned sum, cnt, mine, sp = 0u;
    for (;;) {
        sum = 0u; cnt = 0u; mine = 0u;
#pragma unroll
        for (unsigned j = 0; j < 16; ++j) { const unsigned c = xb_ld(&bar[XB_XCNT(j)]); sum += c; cnt += (c > 0u) ? 1u : 0u; mine = (j == x) ? c : mine; }
        if (sum == G) break;
        __builtin_amdgcn_s_sleep(1);
        if ((++sp & 255u) == 0u) { if (xb_ld(&bar[XB_TMO])) break; if (sp > XB_SPIN_CAP) { atomicAdd(&bar[XB_TMO], 1u); break; } }
    }
    nloc = mine > 0u ? mine : 1u; nx = cnt > 0u ? cnt : 1u;
}

__device__ __forceinline__ void xcd_barrier(const XcdBarrier& b, const int tid) {
    asm volatile("s_waitcnt vmcnt(0)" ::: "memory");
    __syncthreads();
    if (tid == 0) {
        unsigned* bar = b.bar;
        __builtin_amdgcn_s_waitcnt(0);
        unsigned nloc = b.st[0], nx = b.st[1];
        if (nloc == 0u) { xcd_barrier_complete(bar, b.x, nloc, nx); b.st[0] = nloc; b.st[1] = nx; }
        const unsigned old = xb_add(&bar[XB_XSUB(b.x)], 1u);
        const unsigned gen = old / nloc;
        if (old + 1u == (gen + 1u) * nloc) {
            __builtin_amdgcn_fence(__ATOMIC_RELEASE, "agent");
            asm volatile("s_waitcnt vmcnt(0)" ::: "memory");
            const unsigned og = xb_add(&bar[XB_TOP], 1u);
            const unsigned tg = og / nx;
            if (og + 1u == (tg + 1u) * nx) xb_add(&bar[XB_TOPGEN], 1u);
            else XB_SPIN(xb_ld(&bar[XB_TOPGEN]) == tg, bar);
            __builtin_amdgcn_fence(__ATOMIC_ACQUIRE, "agent");
            xb_add(&bar[XB_XGEN(b.x)], 1u);
            asm volatile("s_waitcnt vmcnt(0)" ::: "memory");
        } else {
            XB_SPIN(xb_ld(&bar[XB_XGEN(b.x)]) == gen, bar);
            __builtin_amdgcn_fence(__ATOMIC_ACQUIRE, "agent");
            asm volatile("s_waitcnt vmcnt(0)" ::: "memory");
        }
    }
    __syncthreads();
}

DI int ple_n10(int nblk, int G) { const int npg = 512; const int c0 = (nblk * 8) % G, nf = c0 ? G - c0 : 0, c1 = (nblk * 4) % G, cap11 = c1 ? 2 * (G - c1) : 0;
    const int rem = npg - nf; if (rem <= 0) return npg; int n10 = nf; if (rem > cap11) n10 += ((rem - cap11 + G - 1) / G) * G; return n10 > npg ? npg : n10; }
struct IdleOrder { int n, nN, G, c, c0, base; DI bool next(int i, pg8::Unit& u) const { const int w = c0 ? G - c0 : G, cc = c0 ? c - c0 : c; if (cc < 0) return false; int p = i * w + cc; if (p >= n) return false; p += base; u.pm = p / nN; u.pn = p % nN; return true; } };
struct PleOrder { int nN, G, c; DI bool next(int i, pg8::Unit& u) const { int p; if (G == 256) { if (c >= 128) { if (i >= 3) return false; p = i * 128 + (c - 128); } else { if (i >= 1) return false; p = 384 + c; } } else { p = i * G + c; if (p >= 512) return false; } u.pm = p / nN; u.pn = p % nN; return true; } };
struct SkipOrder { pg8::StaticOrder S; DI bool next(int i, pg8::Unit& u) const { if (!S.next(i, u)) return false; if (u.pn >= DV_OFF / 256) u.pn += DM / 256; return true; } };

constexpr int NPHASE = 13;
__global__ void __launch_bounds__(512, 2) mk_fwd(Args a) {
    extern __shared__ __attribute__((aligned(16))) unsigned char lds_raw[];
    LAS unsigned char* lds = (LAS unsigned char*)lds_raw;
    const int wave = __builtin_amdgcn_readfirstlane((int)threadIdx.x >> 6);
    const int G = gridDim.x, bx = blockIdx.x;
    const int vcu = (G % 8 == 0) ? (bx % 8) * (G / 8) + bx / 8 : bx;
    const int gw = bx * 8 + wave, NGW = G * 8;
    const size_t nthr = (size_t)G * 512;
    typedef __attribute__((address_space(4))) const Args* kargp_t;
    const kargp_t kap = (kargp_t)__builtin_amdgcn_kernarg_segment_ptr();
#define PHASE_VARS const int lane = lane_id(); const int tid = wave * 64 + lane; const size_t gtid = (size_t)bx * 512 + tid; (void)gtid; kargp_t ap = kap; asm volatile("" : "+s"(ap)); unsigned char* const ws = ap->ws; float* const out = ap->out; (void)out; (void)ws;
#define WSP(T, OFF) ((T*)(ws + (OFF)))
    if (kap->ph_lo < 0) { cg::grid_group grid = cg::this_grid(); grid.sync(); }
    const int lo = kap->ph_lo, hi = kap->ph_hi;
#ifndef PHMASK
#define PHMASK 0x1fff
#endif
#define IN(k) (((PHMASK >> (k)) & 1) && lo <= (k) && (k) < hi)
    volatile LAS unsigned* bar_st = (volatile LAS unsigned*)(lds + LDS_BYTES - 32);
    const bool multi_phase = (hi - lo) > 1;
    XcdBarrier bar; bar.bar = nullptr; bar.x = 0; bar.st = bar_st;
    { const int lane0 = lane_id(); const int tid0 = wave * 64 + lane0;
      if (tid0 < 2) bar_st[tid0] = 0u;
      __syncthreads();
      if (multi_phase) bar = xcd_barrier_post((unsigned*)(kap->ws + WS_CTL) + 1024, bar_st, tid0); }
#define SEAM(k) do { if (IN(k) && IN((k) + 1)) { { const int l_ = lane_id(); xcd_barrier(bar, wave * 64 + l_); } } } while (0)

    if (IN(0)) { PHASE_VARS
        const float* x = ap->in[0]; bf16* xb = WSP(bf16, WS_XB); bf16* pb = WSP(bf16, WS_PB); bf16* win_t = WSP(bf16, WS_WIN); bf16* wbrd_t = WSP(bf16, WS_WBRD); bf16* wbrn_t = WSP(bf16, WS_WBRN); bf16* wo_t = WSP(bf16, WS_WO);
        bf16* wpg_t = WSP(bf16, WS_WPG); bf16* wpp_t = WSP(bf16, WS_WPP); bf16* phi1_t = WSP(bf16, WS_PHI1); bf16* phi2_t = WSP(bf16, WS_PHI2); float* bias_in = WSP(float, WS_BIASIN); float* lamp = WSP(float, WS_LAM);
        convert_rows_2(x, xb, WSP(unsigned char, WS_XQ), (size_t)NTOK * DM / 8, gtid, nthr);
        bf16* wmg_q = WSP(bf16, WS_WMGQ);
        convert_rows(ap->in[1], pb, (size_t)NTOK * 256 / 8, gtid, nthr);
        LAS float* scr = (LAS float*)(lds + wave * 16384);
        { constexpr int I0 = 16 * 178, I1 = 16 * 64, I1V = 16 * 32, I1G = 16 * 8, I2 = 16 * 32, I6 = 4 * 32, I7 = 32 * 8, I9 = 4 * 2;
          constexpr int NIT = I0 + I1 + I1V + I1G + 4 * I2 + I6 + 2 * I7 + 2 * I9;
          for (int it = gw; it < NIT; it += NGW) { int r = it; const float* W; int K, N, off; bf16* WT; int nl = -1, ns = -1;
              if (r < I0) { W = ap->in[2]; K = DM; N = CIN; WT = win_t; off = 0; }
              else if ((r -= I0) < I1) { W = ap->in[16]; K = DM; N = 2 * DM; WT = wmg_q; off = 0; }
              else if ((r -= I1) < I1V) { W = ap->in[2] + DV_OFF; K = DM; N = CIN; WT = wmg_q; off = 2 * DM; r = (r >> 5) * ((CIN + 31) >> 5) + (r & 31); }
              else if ((r -= I1V) < I1G) { W = ap->in[2] + NG_OFF; K = DM; N = CIN; WT = wmg_q; off = 3 * DM; r = (r >> 3) * ((CIN + 31) >> 5) + (r & 7); nl = CIN - NG_OFF; ns = 256; }
              else if ((r -= I1G) < I2) { W = ap->in[14]; K = DM; N = DM; WT = wbrd_t; off = 0; }
              else if ((r -= I2) < I2) { W = ap->in[15]; K = DM; N = DM; WT = (bf16*)((unsigned char*)wbrd_t + DM); off = 0; }
              else if ((r -= I2) < I2) { W = ap->in[18]; K = DM; N = DM; WT = wo_t; off = 0; }
              else if ((r -= I2) < I2) { W = ap->in[27]; K = DM; N = DM; WT = wpg_t; off = 0; }
              else if ((r -= I2) < I6) { W = ap->in[29]; K = 256; N = DM; WT = wpp_t; off = 0; }
              else if ((r -= I6) < I7) { W = ap->in[10]; K = 2048; N = 256; WT = phi1_t; off = 0; }
              else if ((r -= I7) < I7) { W = ap->in[12]; K = 2048; N = 256; WT = phi1_t; off = 256; }
              else if ((r -= I7) < I9) { W = ap->in[11]; K = 256; N = 64; WT = phi2_t; off = 0; }
              else { r -= I9; W = ap->in[13]; K = 256; N = 64; WT = phi2_t; off = 256; }
              { const bool br_ = (W == ap->in[14] || W == ap->in[15]); transpose_item<0>(W, K, N, WT, off, scr, r, lane, WT == wpg_t || WT == wmg_q || br_, br_ ? 2 * DM : 0, nl, ns); } } }
        for (size_t i = gtid; i < (size_t)PN; i += nthr) bias_in[i] = i >= (size_t)MG_OFF ? ap->in[17][i - MG_OFF] : 0.f;
        { bf16* b1h = WSP(bf16, WS_B1H); bf16* b2h = WSP(bf16, WS_B2H);
          for (size_t i = gtid; i < (size_t)NEXP * 2 * DFF / 2; i += nthr) *(unsigned*)(b1h + 2 * i) = pk2(ap->in[24][2 * i], ap->in[24][2 * i + 1]);
          for (size_t i = gtid; i < (size_t)NEXP * DM / 2; i += nthr) *(unsigned*)(b2h + 2 * i) = pk2(ap->in[26][2 * i], ap->in[26][2 * i + 1]); }
        if (gtid == 0) { float s1 = 0.f, s2 = 0.f; for (int i = 0; i < 64; ++i) { s1 += ap->in[3][i] * ap->in[4][i]; s2 += ap->in[5][i] * ap->in[6][i]; } lamp[0] = expf(s1) - expf(s2) + LAMBDA_INIT; }
    }
    SEAM(0);
    if (IN(1)) { PHASE_VARS
        bf16* xb = WSP(bf16, WS_XB); bf16* win_t = WSP(bf16, WS_WIN); bf16* proj = WSP(bf16, WS_PROJ); float* bias_in = WSP(float, WS_BIASIN); bf16* pb = WSP(bf16, WS_PB); bf16* wpp_t = WSP(bf16, WS_WPP); bf16* ple = WSP(bf16, WS_PLE);
        { pg8::Gemm g{WSP(bf16, WS_XQ), WSP(bf16, WS_WMGQ), NTOK, 2 * DM, DM / 2}; pg8::StaticOrder S; S.init(NTOK, 3 * DM + 256, G, bx); EpiProjT<true> E{proj, bias_in, MG_OFF / 256, nullptr};
          pg8::gemm_phase<EpiProjT<true>, pg8::StaticOrder, true, true, false, true>(lds, g, S, E, tid); }
        { pg8::Gemm g{xb, win_t, NTOK, MG_OFF, DM}; SkipOrder S; S.S.init(NTOK, MG_OFF - DM - 256, G, bx); EpiProjT<false> E{proj, bias_in, 0, WSP(int, WS_CTL) + 256};
          pg8::gemm_phase<EpiProjT<false>, SkipOrder, true, true>(lds, g, S, E, tid); }
        { pg8::Gemm g{pb, wpp_t, NTOK, DM, 256}; PleOrder S{DM / 256, G, bx}; EpiBf16<0, true> E{ple, DM, 0};
          pg8::gemm_phase<EpiBf16<0, true>, PleOrder, true, true>(lds, g, S, E, tid); }
    }
    SEAM(1);
    constexpr int NCONV = (32 * 512 + 32 * 256) / 8;
#define CONV_UNIT(cu_) do { int lane_v = lane; asm volatile("" : "+v"(lane_v)); LAS float* scr_ = (LAS float*)(lds + wave * 17408); const int it_ = (cu_) * 8 + wave; \
            if (it_ < 32 * 512) { const int e_ = it_ >> 9; transpose_big64<1, true>(ap->in[23] + (size_t)e_ * DM * 2 * DFF, DM, 2 * DFF, (bf16*)((unsigned char*)out + (size_t)e_ * 2 * DFF * DM), scr_, it_ & 511, lane_v, W1SCALE); } \
            else { const int i2_ = it_ - 32 * 512, e_ = i2_ >> 8; bf16* dst_ = (bf16*)(WSP(unsigned char, WS_WE2A) + (size_t)e_ * DM * DFF); \
                   transpose_big64<0, true>(ap->in[25] + (size_t)e_ * DFF * DM, DFF, DM, dst_, scr_, i2_ & 255, lane_v, W2SCALE); } \
            __syncthreads(); } while (0)
#define CONV_DRAIN() do { LAS int* cslot_ = (LAS int*)(lds + LDS_ITEM) + 1; int* cctl_ = WSP(int, WS_CTL); for (;;) { \
            if (tid == 0) *cslot_ = __hip_atomic_fetch_add(cctl_ + 210, 1, __ATOMIC_RELAXED, __HIP_MEMORY_SCOPE_AGENT); \
            __syncthreads(); const int cu_d = __builtin_amdgcn_readfirstlane(*cslot_); __syncthreads(); if (cu_d >= NCONV) break; CONV_UNIT(cu_d); } } while (0)
    if (IN(5)) { PHASE_VARS
        bf16* proj = WSP(bf16, WS_PROJ); bf16* odiff = WSP(bf16, WS_ONSA); bf16* cmpb = WSP(bf16, WS_CMP); float* lamp = WSP(float, WS_LAM); int* ctl = WSP(int, WS_CTL);
        LAS int* item_slot = (LAS int*)(lds + LDS_ITEM);
        const DiffArgs DA{proj, odiff, ap->in[7], lamp, ctl + 256}; const NsaArgs NA{proj, cmpb, odiff};
        { bf16* blk = WSP(bf16, WS_BLK); bf16* hid = WSP(bf16, WS_HID);
          for (int pm = 0; pm < 64; ++pm) {
              { int owner = (pm >> 3) * 32 + (pm & 7); if (owner >= G) owner = pm % G; if (owner != bx) continue; }
              int lane_c = lane; asm volatile("" : "+v"(lane_c)); const int tid_c = wave * 64 + lane_c;
              for (int rr = pm * 256 + wave; rr < pm * 256 + 256; rr += 8) {
                  const int kv = rr >> 13, rem = rr & 8191, bg = rem >> 8, n = rem & 255, b = bg >> 2, g = bg & 3;
                  const int coff = (kv ? VC_OFF : KC_OFF) + g * 64; const float* pos = kv ? ap->in[9] : ap->in[8];
                  bf16* drow = blk + (size_t)rr * 2048;
#pragma unroll
                  for (int jj = 0; jj < 4; ++jj) { const int ch = lane_c + 64 * jj, l = ch >> 3, dd0 = (ch & 7) * 8; u32x4 ov = (u32x4){0u, 0u, 0u, 0u};
                      if (n < 255) { const u32x4 u = *(const u32x4*)(proj + ((size_t)b * SEQ + 16 * n + l) * PN + coff + dd0); f32x4 v0, v1; unpack8(u, v0, v1);
                          const f32x4 p0 = *(const f32x4*)(pos + l * 64 + dd0), p1 = *(const f32x4*)(pos + l * 64 + dd0 + 4); ov = pack8(v0 + p0, v1 + p1); }
                      *(u32x4*)(drow + ch * 8) = ov; } }
              asm volatile("s_waitcnt vmcnt(0)" ::: "memory"); __syncthreads(); __builtin_amdgcn_fence(__ATOMIC_ACQUIRE, "agent"); asm volatile("s_waitcnt vmcnt(0)" ::: "memory");
              { pg8::Gemm g{blk, WSP(bf16, WS_PHI1), 16384, 512, 2048}; OneUnit S{pm, pm >> 5}; EpiBf16<1> E{hid, 256, 1};
                pg8::gemm_phase<EpiBf16<1>, OneUnit, true, true>(lds, g, S, E, tid_c); }
              asm volatile("s_waitcnt vmcnt(0)" ::: "memory"); __syncthreads(); __builtin_amdgcn_fence(__ATOMIC_ACQUIRE, "agent"); asm volatile("s_waitcnt vmcnt(0)" ::: "memory");
              { pg8::Gemm g{hid, WSP(bf16, WS_PHI2), 16384, 512, 256}; OneUnit S{pm, pm >> 5}; EpiBf16<0> E{cmpb, 256, 1};
                pg8::gemm_phase<EpiBf16<0>, OneUnit, true, true>(lds, g, S, E, tid_c); }
              __builtin_amdgcn_fence(__ATOMIC_RELEASE, "agent"); asm volatile("s_waitcnt vmcnt(0)" ::: "memory"); __syncthreads();
              if (wave == 0) __hip_atomic_fetch_add(ctl + 201, 1, __ATOMIC_RELAXED, __HIP_MEMORY_SCOPE_AGENT);
          } }
        bool cmp_ok = false;
        const int xq = (int)(xb_xcc_id() & 7u);
        for (int qi = 0; qi < 8; ++qi) {
            const int q = (xq + qi) & 7;
            for (;;) {
                if (tid == 0) *item_slot = __hip_atomic_fetch_add(ctl + 64 + 16 * q, 1, __ATOMIC_RELAXED, __HIP_MEMORY_SCOPE_AGENT);
                __syncthreads();
                const int item = __builtin_amdgcn_readfirstlane(*item_slot);
                __syncthreads();
                if (item >= 512) break;
                if (item < 256) { const int qb = 31 - (item & 31), bh = q * 8 + (7 - (item >> 5));
#ifndef NO_DIFF
 diff_unit(DA, bh >> 3, bh & 7, qb, lds, tid);
#endif
                } else { const int i2 = item - 256, qb = 63 - (i2 & 63), bg = q * 4 + (3 - (i2 >> 6));
#ifndef NO_NSA
                    if (!cmp_ok) { if (wave == 0) { unsigned sp = 0; while (__builtin_amdgcn_readfirstlane(__hip_atomic_load(ctl + 201, __ATOMIC_RELAXED, __HIP_MEMORY_SCOPE_AGENT)) < 64 * 64) { __builtin_amdgcn_s_sleep(8); if (++sp > (1u << 22)) break; }
                            __builtin_amdgcn_fence(__ATOMIC_ACQUIRE, "agent"); asm volatile("s_waitcnt vmcnt(0)" ::: "memory"); }
                        __syncthreads(); cmp_ok = true; }
 nsa_unit(NA, bg >> 2, bg & 3, qb, lds, tid);
#endif
                }
            }
        }
        CONV_DRAIN();
    }
    SEAM(5);
    if (IN(6)) { PHASE_VARS
        bf16* proj = WSP(bf16, WS_PROJ); bf16* odiff = WSP(bf16, WS_ONSA); bf16* wbrd_t = WSP(bf16, WS_WBRD); bf16* wbrn_t = WSP(bf16, WS_WBRN); bf16* mixed = WSP(bf16, WS_MIXED);
        { pg8::Gemm g{odiff, wbrd_t, NTOK, DM, DM}; pg8::StaticOrder S; S.init(NTOK, DM, G, bx); EpiBrM E{proj, mixed};
          pg8::gemm_phase<EpiBrM, pg8::StaticOrder, true, true, false, true>(lds, g, S, E, tid); }
    }
    SEAM(6);
    if (IN(7)) { PHASE_VARS
        const bf16* x = WSP(bf16, WS_XB); bf16* mixed = WSP(bf16, WS_MIXED); bf16* wo_t = WSP(bf16, WS_WO);
        CONV_DRAIN();
        { pg8::Gemm g{mixed, wo_t, NTOK, DM, DM}; pg8::StaticOrder S; S.init(NTOK, DM, G, bx); EpiHpre E{x, WSP(bf16, WS_HPRE)};
          pg8::gemm_phase<EpiHpre, pg8::StaticOrder, true, true>(lds, g, S, E, tid); }
    }
    SEAM(7);
    if (IN(8)) { PHASE_VARS
        bf16* hb = WSP(bf16, WS_HB); int* tope = WSP(int, WS_TOPE); float* gate = WSP(float, WS_GATE); int* posg = WSP(int, WS_POS); int* ctl = WSP(int, WS_CTL);
        LAS float* wl = (LAS float*)lds;
        LAS float* lg = (LAS float*)(lds + 131072 + 512);
        LAS int* lcnt = (LAS int*)(lds + 135168 + 512);
        LAS int* lbase = lcnt + 32;
        LAS int* ent_e = (LAS int*)(lds + 135424 + 512);
        LAS int* ent_lp = ent_e + 512;
        const float* wr = ap->in[21]; const float* br = ap->in[22]; const float* g1 = ap->in[19]; const float* b1 = ap->in[20];
        { int* slot_tok = WSP(int, WS_SLOTTOK); for (size_t i = gtid; i < (size_t)MAXSLOT; i += nthr) slot_tok[i] = 0; }
        for (int i = tid; i < 32768; i += 512) { const int col = i >> 5, jh = col >> 9, l_ = (col & 511) >> 3, w_ = col & 7;
            wl[(i & 31) * 1028 + 512 * jh + (w_ < 4 ? 4 * l_ + w_ : 256 + 4 * l_ + (w_ - 4))] = wr[i]; }
        for (int chunk = bx; chunk < NTOK / 128; chunk += G) {
            if (tid < 32) lcnt[tid] = 0;
            __syncthreads();
            const int row0 = chunk * 128 + wave * 16;
            u32x4 nx[4][2];
#pragma unroll
            for (int r = 0; r < 4; ++r)
#pragma unroll
                for (int j = 0; j < 2; ++j) nx[r][j] = __builtin_nontemporal_load((const u32x4*)(WSP(bf16, WS_HPRE) + (size_t)(row0 + r) * DM + 8 * lane + 512 * j));
            for (int grp = 0; grp < 4; ++grp) {
                float hv[4][16];
#pragma unroll
                for (int r = 0; r < 4; ++r) { const size_t row = (size_t)(row0 + grp * 4 + r);
                    f32x4 v[4]; float s = 0.f;
#pragma unroll
                    for (int j = 0; j < 2; ++j) { v[2 * j] = (f32x4){bflo(nx[r][j].x), bfhi(nx[r][j].x), bflo(nx[r][j].y), bfhi(nx[r][j].y)}; v[2 * j + 1] = (f32x4){bflo(nx[r][j].z), bfhi(nx[r][j].z), bflo(nx[r][j].w), bfhi(nx[r][j].w)}; }
#pragma unroll
                    for (int j = 0; j < 4; ++j) s += (v[j][0] + v[j][1]) + (v[j][2] + v[j][3]);
                    { const int gn = grp < 3 ? grp + 1 : 3;
#pragma unroll
                      for (int j = 0; j < 2; ++j) nx[r][j] = __builtin_nontemporal_load((const u32x4*)(WSP(bf16, WS_HPRE) + (size_t)(row0 + gn * 4 + r) * DM + 8 * lane + 512 * j)); }
                    const float mean = wave_sum(s) * (1.0f / DM); float s2 = 0.f;
#pragma unroll
                    for (int j = 0; j < 4; ++j) { v[j] = v[j] - mean; s2 += (v[j][0] * v[j][0] + v[j][1] * v[j][1]) + (v[j][2] * v[j][2] + v[j][3] * v[j][3]); }
                    const float rstd = 1.0f / sqrtf(wave_sum(s2) * (1.0f / DM) + LN_EPS);
                    if (lane == 0) *(f32x2_t*)(WSP(float, WS_HB) + row * 2) = (f32x2_t){mean, rstd};
#pragma unroll
                    for (int jh = 0; jh < 2; ++jh) { const int co = 512 * jh + 8 * lane; f32x4 h4[2];
#pragma unroll
                        for (int hh = 0; hh < 2; ++hh) { const int j = 2 * jh + hh; const f32x4 gg = *(const f32x4*)(g1 + co + 4 * hh), bb = *(const f32x4*)(b1 + co + 4 * hh);
                            h4[hh] = v[j] * rstd * gg + bb;
                            hv[r][4 * j] = h4[hh][0]; hv[r][4 * j + 1] = h4[hh][1]; hv[r][4 * j + 2] = h4[hh][2]; hv[r][4 * j + 3] = h4[hh][3]; }
                        u32x2 q8; q8.x = pack4_fp8(h4[0][0], h4[0][1], h4[0][2], h4[0][3]); q8.y = pack4_fp8(h4[1][0], h4[1][1], h4[1][2], h4[1][3]);
                        *(u32x2*)(WSP(unsigned char, WS_HQ) + row * DM + co) = q8; } }
#pragma unroll 1
                for (int ec = 0; ec < 4; ++ec) {
                    float ac[32];
                    { f32x2_t a2[16];
#pragma unroll
                      for (int i = 0; i < 16; ++i) a2[i] = (f32x2_t){0.f, 0.f};
#pragma unroll
                      for (int el = 0; el < 8; ++el)
#pragma unroll
                          for (int j = 0; j < 4; ++j) { const f32x4 w4 = *(const LAS f32x4*)(wl + (8 * ec + el) * 1028 + 256 * j + 4 * lane);
#pragma unroll
                              for (int c4 = 0; c4 < 4; ++c4) { const f32x2_t wv = (f32x2_t){w4[c4], w4[c4]};
                                  a2[2 * el] = __builtin_elementwise_fma((f32x2_t){hv[0][4 * j + c4], hv[1][4 * j + c4]}, wv, a2[2 * el]);
                                  a2[2 * el + 1] = __builtin_elementwise_fma((f32x2_t){hv[2][4 * j + c4], hv[3][4 * j + c4]}, wv, a2[2 * el + 1]); } }
#pragma unroll
                      for (int el = 0; el < 8; ++el) { ac[el * 4] = a2[2 * el].x; ac[el * 4 + 1] = a2[2 * el].y; ac[el * 4 + 2] = a2[2 * el + 1].x; ac[el * 4 + 3] = a2[2 * el + 1].y; } }
#define BFLY(N, OFF, CTRL) _Pragma("unroll") for (int i = 0; i < (N); ++i) { const bool up_ = (lane & (OFF)) != 0; const float send_ = up_ ? ac[i] : ac[i + (N)], keep_ = up_ ? ac[i + (N)] : ac[i]; ac[i] = keep_ + dpp_get<CTRL>(send_); }
#pragma unroll
                    for (int i = 0; i < 16; ++i) { const auto rr = __builtin_amdgcn_permlane32_swap(__float_as_uint(ac[i]), __float_as_uint(ac[i + 16]), false, false); ac[i] = __uint_as_float(rr[0]) + __uint_as_float(rr[1]); }
#pragma unroll
                    for (int i = 0; i < 8; ++i) { const auto rr = __builtin_amdgcn_permlane16_swap(__float_as_uint(ac[i]), __float_as_uint(ac[i + 8]), false, false); ac[i] = __uint_as_float(rr[0]) + __uint_as_float(rr[1]); }
                    BFLY(4, 8, 0x140) BFLY(2, 4, 0x141) BFLY(1, 2, 0x4E)
#undef BFLY
                    const float tot = ac[0] + dpp_get<0xB1>(ac[0]);
                    const int idx = lane >> 1, el = idx >> 2, r = idx & 3;
                    if (!(lane & 1)) lg[(wave * 4 + r) * 32 + 8 * ec + el] = tot + br[8 * ec + el];
                }
#pragma unroll 1
                for (int rr = 0; rr < 4; rr += 2) { const int r = rr + (lane >> 5), e = lane & 31; const LAS float* lr = lg + (wave * 4 + r) * 32;
                    const float v = lr[e]; int rank = 0;
                    for (int j = 0; j < 32; ++j) { const float vj = lr[j]; rank += (vj > v || (vj == v && j < e)) ? 1 : 0; }
                    float vmax = v;
#pragma unroll
                    for (int o = 0; o < 1; ++o) vmax = row16_max(sw16_max(vmax));
                    const float ex = rank < 4 ? __builtin_amdgcn_exp2f((v - vmax) * LOG2E) : 0.f; float s = ex;
#pragma unroll
                    for (int o = 0; o < 1; ++o) s = row16_sum(sw16_sum(s));
                    if (rank < 4) { const int t = row0 + grp * 4 + r; const int lp = __hip_atomic_fetch_add(lcnt + e, 1, __ATOMIC_RELAXED, __HIP_MEMORY_SCOPE_WORKGROUP);
                        const int ix = (t - chunk * 128) * 4 + rank; ent_e[ix] = e; ent_lp[ix] = lp; tope[t * 4 + rank] = e; gate[t * 4 + rank] = ex / s; }
                }
            }
            __syncthreads();
            if (tid < 32) lbase[tid] = __hip_atomic_fetch_add(ctl + tid, lcnt[tid], __ATOMIC_RELAXED, __HIP_MEMORY_SCOPE_AGENT);
            __syncthreads();
            posg[chunk * 512 + tid] = lbase[ent_e[tid]] + ent_lp[tid];
            __syncthreads();
        }
    }
    SEAM(8);
    if (IN(9)) { PHASE_VARS
        bf16* hb = WSP(bf16, WS_HB); bf16* xg = WSP(bf16, WS_XG); int* tope = WSP(int, WS_TOPE); float* gate = WSP(float, WS_GATE); int* posg = WSP(int, WS_POS); int* slot_of = WSP(int, WS_SLOTOF); float* slot_gate = WSP(float, WS_SLOTGATE); int* blk_e = WSP(int, WS_BLKE); int* ctl = WSP(int, WS_CTL);
        LAS int* bst = (LAS int*)lds;
        if (tid == 0) { int acc = 0; for (int e = 0; e < 32; ++e) { bst[e] = acc; acc += (ctl[e] + 255) >> 8; } bst[32] = acc; }
        __syncthreads();
        if (bx == 0) { for (int e = wave; e < 32; e += 8) for (int pm = bst[e] + lane; pm < bst[e + 1]; pm += 64) blk_e[pm] = e;
            if (tid == 0) blk_e[MAXBLK] = bst[32]; }
        { int* slot_tok = WSP(int, WS_SLOTTOK);
          for (size_t as = gtid; as < (size_t)NTOK * 4; as += nthr) { const int t = (int)(as >> 2), e = tope[as]; const int slot = 256 * bst[e] + posg[as];
              slot_of[as] = slot; slot_gate[slot] = gate[as]; slot_tok[slot] = t; } }
    }
    SEAM(9);
    if (IN(10)) { PHASE_VARS
        bf16* xg = WSP(bf16, WS_XG); bf16* we1_t = (bf16*)out; bf16* act = WSP(bf16, WS_ACT); bf16* hb = WSP(bf16, WS_HB); bf16* wpg_t = WSP(bf16, WS_WPG); bf16* ple = WSP(bf16, WS_PLE); int* blk_e = WSP(int, WS_BLKE);
        const int nblk = __builtin_amdgcn_readfirstlane(blk_e[MAXBLK]);
        { pg8::Gemm g{WSP(bf16, WS_HQ), we1_t, nblk * 256, NEXP * 2 * DFF, DM / 2}; GroupedOrder S{blk_e, nblk, 8, G, vcu, 1 << 30, 0}; EpiFfn1T<true> E{act, WSP(bf16, WS_B1H)};
          pg8::gemm_phase<EpiFfn1T<true>, GroupedOrder, true, true, true, true>(lds, g, S, E, tid, WSP(int, WS_SLOTTOK)); }
        { const int c0 = (nblk * 8) % G; const int n10 = ple_n10(nblk, G);
          pg8::Gemm g{WSP(bf16, WS_HQ), wpg_t, NTOK, DM, DM / 2}; FillOrder S{n10, DM / 256, G, vcu, c0, 0}; EpiPleT<true> E{ple, ap->in[28]};
          pg8::gemm_phase<EpiPleT<true>, FillOrder, true, true, false, true>(lds, g, S, E, tid); }
    }
    SEAM(10);
    if (IN(11)) { PHASE_VARS
        bf16* xg = WSP(bf16, WS_XG); bf16* we2_t = WSP(bf16, WS_WE2A); bf16* act = WSP(bf16, WS_ACT); float* slot_gate = WSP(float, WS_SLOTGATE); int* blk_e = WSP(int, WS_BLKE);
        const int nblk = __builtin_amdgcn_readfirstlane(blk_e[MAXBLK]);
        { pg8::Gemm g{act, we2_t, nblk * 256, NEXP * DM, DFF / 2}; GroupedOrder S{blk_e, nblk, 4, G, vcu, 1 << 30, 0}; EpiFfn2T<true> E{xg, WSP(bf16, WS_B2H)};
          pg8::gemm_phase<EpiFfn2T<true>, GroupedOrder, true, true, false, true>(lds, g, S, E, tid); }
        { const int npg = 512; const int n10 = ple_n10(nblk, G);
          if (n10 < npg) { pg8::Gemm g{WSP(bf16, WS_HQ), WSP(bf16, WS_WPG), NTOK, DM, DM / 2}; IdleOrder S{npg - n10, DM / 256, G, vcu, (nblk * 4) % G, n10}; EpiPleT<true> E{WSP(bf16, WS_PLE), ap->in[28]};
              pg8::gemm_phase<EpiPleT<true>, IdleOrder, true, true, false, true>(lds, g, S, E, tid); } }
    }
    SEAM(11);
    if (IN(12)) { PHASE_VARS
        bf16* xg = WSP(bf16, WS_XG); bf16* ple = WSP(bf16, WS_PLE); int* slot_of = WSP(int, WS_SLOTOF); bf16* hb = WSP(bf16, WS_HB);
        const float* g2 = ap->in[30]; const float* b2 = ap->in[31];
        const float* gate = WSP(float, WS_GATE);
        const bf16* hpre = WSP(bf16, WS_HPRE); const float* stat = WSP(float, WS_HB);
        f32x2_t mraw = *(const f32x2_t*)(stat + (size_t)gw * 2);
        int sraw[4]; float graw[4];
#pragma unroll
        for (int k = 0; k < 4; ++k) { sraw[k] = slot_of[gw * 4 + k]; graw[k] = gate[gw * 4 + k]; }
        f32x4 gg[4], bb[4];
#pragma unroll
        for (int q = 0; q < 4; ++q) { gg[q] = *(const f32x4*)(g2 + 512 * (q >> 1) + 8 * lane + 4 * (q & 1)); bb[q] = *(const f32x4*)(b2 + 512 * (q >> 1) + 8 * lane + 4 * (q & 1)); }
        f32x4 ga[4], ba[4];
#pragma unroll
        for (int q = 0; q < 4; ++q) { ga[q] = *(const f32x4*)(ap->in[19] + 512 * (q >> 1) + 8 * lane + 4 * (q & 1)) * DN_ALPHA; ba[q] = *(const f32x4*)(ap->in[20] + 512 * (q >> 1) + 8 * lane + 4 * (q & 1)) * DN_ALPHA; }
        for (int t = gw; t < NTOK; t += NGW) {
            float* hp = out + (size_t)t * DM + 8 * lane; f32x4 v[4];
            int sl[4];
#pragma unroll
            for (int k = 0; k < 4; ++k) sl[k] = __builtin_amdgcn_readfirstlane(sraw[k]);
            float gk[4];
#pragma unroll
            for (int k = 0; k < 4; ++k) gk[k] = __builtin_bit_cast(float, __builtin_amdgcn_readfirstlane(__builtin_bit_cast(int, graw[k])));
            const float mean1 = mraw.x, rstd1 = mraw.y;
            { const int tn = t + NGW < NTOK ? t + NGW : t;
              mraw = *(const f32x2_t*)(stat + (size_t)tn * 2);
#pragma unroll
              for (int k = 0; k < 4; ++k) { sraw[k] = slot_of[tn * 4 + k]; graw[k] = gate[tn * 4 + k]; } }
            float s = 0.f;
#pragma unroll
            for (int jh = 0; jh < 2; ++jh) { const size_t co = (size_t)512 * jh + 8 * lane;
                { const u32x4 hw = __builtin_nontemporal_load((const u32x4*)(hpre + (size_t)t * DM + co));
                  const f32x4 a0 = ga[2 * jh] * rstd1, a1 = ga[2 * jh + 1] * rstd1;
                  v[2 * jh] = (f32x4){bflo(hw.x), bfhi(hw.x), bflo(hw.y), bfhi(hw.y)} * a0 + (ba[2 * jh] - a0 * mean1); v[2 * jh + 1] = (f32x4){bflo(hw.z), bfhi(hw.z), bflo(hw.w), bfhi(hw.w)} * a1 + (ba[2 * jh + 1] - a1 * mean1); }
                { const u32x4 pw = __builtin_nontemporal_load((const u32x4*)(ple + (size_t)t * DM + co));
                  v[2 * jh] += (f32x4){bflo(pw.x), bfhi(pw.x), bflo(pw.y), bfhi(pw.y)}; v[2 * jh + 1] += (f32x4){bflo(pw.z), bfhi(pw.z), bflo(pw.w), bfhi(pw.w)}; }
                { f32x4 ya = (f32x4){0.f, 0.f, 0.f, 0.f}, yb = ya;
#pragma unroll
                  for (int k = 0; k < 4; ++k) { const u32x2 yw = __builtin_nontemporal_load((const u32x2*)((const unsigned char*)xg + (size_t)sl[k] * DM + co));
                      const f32x2_t l0 = __builtin_amdgcn_cvt_pk_f32_fp8((int)yw.x, false), h0 = __builtin_amdgcn_cvt_pk_f32_fp8((int)yw.x, true), l1 = __builtin_amdgcn_cvt_pk_f32_fp8((int)yw.y, false), h1 = __builtin_amdgcn_cvt_pk_f32_fp8((int)yw.y, true);
                      ya += (f32x4){l0.x, l0.y, h0.x, h0.y} * gk[k]; yb += (f32x4){l1.x, l1.y, h1.x, h1.y} * gk[k]; }
                  v[2 * jh] += ya * (1.0f / YSCALE); v[2 * jh + 1] += yb * (1.0f / YSCALE); }
                s += ((v[2 * jh][0] + v[2 * jh][1]) + (v[2 * jh][2] + v[2 * jh][3])) + ((v[2 * jh + 1][0] + v[2 * jh + 1][1]) + (v[2 * jh + 1][2] + v[2 * jh + 1][3])); }
            const float mean = wave_sum(s) * (1.0f / DM); float s2 = 0.f;
#pragma unroll
            for (int j = 0; j < 4; ++j) { v[j] = v[j] - mean; s2 += (v[j][0] * v[j][0] + v[j][1] * v[j][1]) + (v[j][2] * v[j][2] + v[j][3] * v[j][3]); }
            const float rstd = 1.0f / sqrtf(wave_sum(s2) * (1.0f / DM) + LN_EPS);
#pragma unroll
            for (int q = 0; q < 4; ++q) *(f32x4*)(hp + 512 * (q >> 1) + 4 * (q & 1)) = v[q] * rstd * gg[q] + bb[q];
        }
    }
#undef IN
#undef SEAM
}

#ifndef MK_MULTI
#define MK_MULTI 0
#endif
extern "C" void kernel_launch(void* const* d_in, const int* in_sizes, int n_in, void* d_out, int out_size, void* d_ws, size_t ws_size, hipStream_t stream) {
    static int grid = 0;
    if (grid == 0) {
        if (n_in != 32 || out_size != NTOK * DM || ws_size < WS_NEED) { fprintf(stderr, "kernel_launch: unexpected shapes (n_in %d, out %d, ws %zu)\n", n_in, out_size, ws_size); grid = -1; return; }
        int dev = 0, cus = 0, per_cu = 0;
        hipGetDevice(&dev); hipDeviceGetAttribute(&cus, hipDeviceAttributeMultiprocessorCount, dev);
        hipFuncSetAttribute((const void*)mk_fwd, hipFuncAttributeMaxDynamicSharedMemorySize, LDS_BYTES);
        hipOccupancyMaxActiveBlocksPerMultiprocessor(&per_cu, (const void*)mk_fwd, 512, LDS_BYTES);
        (void)hipGetLastError();
        if (per_cu < 1) { fprintf(stderr, "kernel_launch: occupancy query says %d blocks per CU\n", per_cu); per_cu = 1; }
        grid = cus;
        if (grid > cus * per_cu) grid = cus * per_cu;
    }
    if (grid < 0) return;
    hipMemsetAsync((char*)d_ws + WS_CTL, 0, CTL_BYTES, stream);
    Args a{};
    for (int i = 0; i < 32; ++i) a.in[i] = (const float*)d_in[i];
    a.out = (float*)d_out; a.ws = (unsigned char*)d_ws;
#if MK_MULTI
    for (int p = 0; p < NPHASE; ++p) { a.ph_lo = p; a.ph_hi = p + 1; hipLaunchKernelGGL(mk_fwd, dim3(grid), dim3(512), LDS_BYTES, stream, a); }
#else
    a.ph_lo = 0; a.ph_hi = NPHASE;
    void* args[] = {&a};
    hipError_t e = hipLaunchCooperativeKernel((const void*)mk_fwd, dim3(grid), dim3(512), args, LDS_BYTES, stream);
    if (e != hipSuccess) fprintf(stderr, "cooperative launch failed: %s (grid %d)\n", hipGetErrorString(e), grid);
#endif
}
```
